# Optimizing an MI355X kernel written in HIP

```python
import math
import jax, jax.numpy as jnp
from jax import lax
import numpy as np

D_MODEL = 2048
BATCH = 1
SEQ = 8192
DEPTH = 1

HEAD_DIM = 128
N_HEADS = D_MODEL // HEAD_DIM
MOBA_HEADS = N_HEADS // 2
NSA_HEADS = N_HEADS - MOBA_HEADS
NSA_KV_HEADS = 2
NSA_GROUP = NSA_HEADS // NSA_KV_HEADS
MOBA_BLOCK = 256
MOBA_TOPK = 3
CMP_LEN = 32
CMP_STRIDE = 16
SLC_LEN = 64
SLC_TOPK = 16
WINDOW = 512
N_BUCKETS = 32
MAX_DISTANCE = 128
D_FF = 4 * D_MODEL
D_PLE = 256
Q_CHUNK = 128
LN_EPS = 1e-5
DN_ALPHA = (2 * DEPTH) ** 0.25
DN_BETA = (8 * DEPTH) ** -0.25
NEG_INF = -1e30
TINY = 1e-30
FORCE_SCORE = 1e4

MOBA_W = MOBA_HEADS * HEAD_DIM
NSA_Q_W = NSA_HEADS * HEAD_DIM
NSA_KV_W = NSA_KV_HEADS * HEAD_DIM
GATE_W = NSA_HEADS * 3
SPLIT_SIZES = [MOBA_W, MOBA_W, MOBA_W, NSA_Q_W] + [NSA_KV_W] * 6 + [GATE_W]
PROJ_W = sum(SPLIT_SIZES)

kernel_name = "hymba_moba_nsa_deepnorm_hybrid"


def layer_norm(x, g, b):
    xf = x.astype(jnp.float32)
    mu = jnp.mean(xf, axis=-1, keepdims=True)
    var = jnp.mean(jnp.square(xf - mu), axis=-1, keepdims=True)
    y = (xf - mu) * lax.rsqrt(var + LN_EPS)
    return (y * g.astype(jnp.float32) + b.astype(jnp.float32)).astype(x.dtype)


def t5_bucket(dist):
    n = jnp.maximum(dist, 0)
    max_exact = N_BUCKETS // 2
    large = max_exact + (jnp.log(jnp.maximum(n, 1).astype(jnp.float32) / max_exact)
                         / math.log(MAX_DISTANCE / max_exact) * (N_BUCKETS - max_exact)).astype(jnp.int32)
    large = jnp.minimum(large, N_BUCKETS - 1)
    return jnp.where(n < max_exact, n, large)


def masked_softmax(logits, mask):
    logits = jnp.where(mask, logits.astype(jnp.float32), NEG_INF)
    m = jnp.max(logits, axis=-1, keepdims=True)
    e = jnp.where(mask, jnp.exp(logits - m), 0.0)
    return e / jnp.maximum(jnp.sum(e, axis=-1, keepdims=True), TINY)


def compress(kv, pe, w1, w2):
    S = kv.shape[1]
    n_cmp = (S - CMP_LEN) // CMP_STRIDE + 1
    idx = jnp.arange(n_cmp)[:, None] * CMP_STRIDE + jnp.arange(CMP_LEN)[None, :]
    blocks = kv[:, idx] + pe[:, None, :]
    h = jax.nn.gelu(jnp.einsum('bnlgd,lde->bnge', blocks, w1))
    return jnp.einsum('bnge,ef->bngf', h, w2)


def hybrid_mixer(x, w_in, cmp_pe_k, cmp_w1_k, cmp_w2_k, cmp_pe_v, cmp_w1_v, cmp_w2_v, tab_flat, w_out):
    B, S, _ = x.shape
    dt = x.dtype
    scale = HEAD_DIM ** -0.5
    z = x @ w_in
    offs = [int(o) for o in np.cumsum(SPLIT_SIZES)[:-1]]
    mq, mk, mv, nq, ck, cv, sk, sv, wk, wv, gl = jnp.split(z, offs, axis=-1)
    Hm, Hn, G, R, Dh = MOBA_HEADS, NSA_HEADS, NSA_KV_HEADS, NSA_GROUP, HEAD_DIM
    mq = mq.reshape(B, S, Hm, Dh)
    mk = mk.reshape(B, S, Hm, Dh)
    mv = mv.reshape(B, S, Hm, Dh)
    nq = nq.reshape(B, S, G, R, Dh)
    ck, cv, sk, sv, wk, wv = [a.reshape(B, S, G, Dh) for a in (ck, cv, sk, sv, wk, wv)]
    gates = jax.nn.sigmoid(gl).reshape(B, S, G, R, 3)

    L = MOBA_BLOCK
    nb = -(-S // L)
    pad = nb * L - S
    mk_p = jnp.pad(mk, ((0, 0), (0, pad), (0, 0), (0, 0)))
    mv_p = jnp.pad(mv, ((0, 0), (0, pad), (0, 0), (0, 0)))
    kb = mk_p.reshape(B, nb, L, Hm, Dh).transpose(0, 3, 1, 2, 4)
    vb = mv_p.reshape(B, nb, L, Hm, Dh).transpose(0, 3, 1, 2, 4)
    kmean = jnp.mean(kb, axis=3)
    k_moba = min(MOBA_TOPK, nb)
    sel_ok_moba_rank = jnp.arange(k_moba)

    kc = compress(ck, cmp_pe_k, cmp_w1_k, cmp_w2_k)
    vc = compress(cv, cmp_pe_v, cmp_w1_v, cmp_w2_v)
    n_cmp = kc.shape[1]
    cmp_start = jnp.arange(n_cmp) * CMP_STRIDE
    cmp_end = cmp_start + CMP_LEN - 1
    n_slc = S // SLC_LEN
    k_slc = min(SLC_TOPK, n_slc)
    slc_start = jnp.arange(n_slc) * SLC_LEN
    overlap = ((cmp_start[:, None] < slc_start[None, :] + SLC_LEN)
               & (cmp_start[:, None] + CMP_LEN > slc_start[None, :])).astype(jnp.float32)
    skb = sk.reshape(B, n_slc, SLC_LEN, G, Dh).transpose(0, 3, 1, 2, 4)
    svb = sv.reshape(B, n_slc, SLC_LEN, G, Dh).transpose(0, 3, 1, 2, 4)
    wk_p = jnp.pad(wk, ((0, 0), (WINDOW, 0), (0, 0), (0, 0)))
    wv_p = jnp.pad(wv, ((0, 0), (WINDOW, 0), (0, 0), (0, 0)))

    hm = jnp.arange(Hm)
    hn = MOBA_HEADS + jnp.arange(Hn).reshape(G, R)
    bi = jnp.arange(B)[:, None, None, None]

    def chunk(c):
        q0 = c * Q_CHUNK
        t = q0 + jnp.arange(Q_CHUNK)
        qm = lax.dynamic_slice_in_dim(mq, q0, Q_CHUNK, 1)
        blk = q0 // L
        gate_s = jnp.einsum('bchd,bhnd->bchn', qm, kmean).astype(jnp.float32)
        gate_s = jnp.where(jnp.arange(nb) < blk, gate_s, NEG_INF)
        _, sel = lax.top_k(gate_s, k_moba)
        sel_ok = jnp.repeat(sel_ok_moba_rank < blk, L)
        hi = hm[None, None, :, None]
        kg = kb[bi, hi, sel]
        vg = vb[bi, hi, sel]
        kL = k_moba * L
        lg_sel = jnp.einsum('bchd,bchksd->bchks', qm, kg).reshape(B, Q_CHUNK, Hm, kL)
        pos_sel = (sel[..., None] * L + jnp.arange(L)).reshape(B, Q_CHUNK, Hm, kL)
        bias_sel = tab_flat[hm[None, None, :, None] * N_BUCKETS
                            + t5_bucket(t[None, :, None, None] - pos_sel)]
        k_own = lax.dynamic_slice_in_dim(mk_p, blk * L, L, 1)
        v_own = lax.dynamic_slice_in_dim(mv_p, blk * L, L, 1)
        lg_own = jnp.einsum('bchd,bshd->bchs', qm, k_own)
        pos_own = blk * L + jnp.arange(L)
        dist_own = t[:, None] - pos_own[None, :]
        bias_own = tab_flat[hm[None, :, None] * N_BUCKETS + t5_bucket(dist_own)[:, None, :]]
        logits_m = jnp.concatenate([lg_sel.astype(jnp.float32) * scale + bias_sel,
                                    lg_own.astype(jnp.float32) * scale + bias_own[None]], axis=-1)
        mask_m = jnp.concatenate([
            jnp.broadcast_to(sel_ok, (B, Q_CHUNK, Hm, kL)),
            jnp.broadcast_to((dist_own >= 0)[None, :, None, :], (B, Q_CHUNK, Hm, L))], axis=-1)
        prob_m = masked_softmax(logits_m, mask_m).astype(dt)
        o_m = (jnp.einsum('bchks,bchksd->bchd', prob_m[..., :kL].reshape(B, Q_CHUNK, Hm, k_moba, L), vg)
               + jnp.einsum('bchs,bshd->bchd', prob_m[..., kL:], v_own))
        qn = lax.dynamic_slice_in_dim(nq, q0, Q_CHUNK, 1)
        lg_c = jnp.einsum('bcgrd,bngd->bcgrn', qn, kc).astype(jnp.float32) * scale
        dist_c = t[:, None] - cmp_end[None, :]
        bias_c = tab_flat[hn[None, :, :, None] * N_BUCKETS + t5_bucket(dist_c)[:, None, None, :]]
        p_c = masked_softmax(lg_c + bias_c[None], (dist_c >= 0)[None, :, None, None, :])
        o_c = jnp.einsum('bcgrn,bngd->bcgrd', p_c.astype(dt), vc)
        imp = jnp.einsum('bcgrn,nj->bcgj', p_c, overlap)
        jj = jnp.arange(n_slc)
        cur = t // SLC_LEN
        allowed = (slc_start[None, :] <= t[:, None])[None, :, None, :]
        forced = ((jj[None, :] == 0) | (jj[None, :] == cur[:, None])
                  | (jj[None, :] == cur[:, None] - 1))[None, :, None, :]
        score = jnp.where(allowed, jnp.where(forced, FORCE_SCORE, imp), -1.0)
        top_v, sel_n = lax.top_k(score, k_slc)
        gi = jnp.arange(G)[None, None, :, None]
        ksel = skb[bi, gi, sel_n]
        vsel = svb[bi, gi, sel_n]
        kLs = k_slc * SLC_LEN
        lg_s = jnp.einsum('bcgrd,bcgksd->bcgrks', qn, ksel).reshape(B, Q_CHUNK, G, R, kLs)
        pos_s = (sel_n[..., None] * SLC_LEN + jnp.arange(SLC_LEN)).reshape(B, Q_CHUNK, G, kLs)
        dist_s = t[None, :, None, None] - pos_s
        mask_s = (jnp.repeat(top_v >= 0, SLC_LEN, axis=-1) & (dist_s >= 0))[:, :, :, None, :]
        bias_s = tab_flat[hn[None, None, :, :, None] * N_BUCKETS + t5_bucket(dist_s)[:, :, :, None, :]]
        p_s = masked_softmax(lg_s.astype(jnp.float32) * scale + bias_s, mask_s)
        o_s = jnp.einsum('bcgrks,bcgksd->bcgrd',
                         p_s.reshape(B, Q_CHUNK, G, R, k_slc, SLC_LEN).astype(dt), vsel)
        kw = lax.dynamic_slice_in_dim(wk_p, q0, Q_CHUNK + WINDOW, 1)
        vw = lax.dynamic_slice_in_dim(wv_p, q0, Q_CHUNK + WINDOW, 1)
        pos_w = q0 - WINDOW + jnp.arange(Q_CHUNK + WINDOW)
        dist_w = t[:, None] - pos_w[None, :]
        mask_w = (dist_w >= 0) & (dist_w < WINDOW) & (pos_w[None, :] >= 0)
        bias_w = tab_flat[hn[None, :, :, None] * N_BUCKETS + t5_bucket(dist_w)[:, None, None, :]]
        lg_w = jnp.einsum('bcgrd,bsgd->bcgrs', qn, kw).astype(jnp.float32) * scale + bias_w[None]
        p_w = masked_softmax(lg_w, mask_w[None, :, None, None, :])
        o_w = jnp.einsum('bcgrs,bsgd->bcgrd', p_w.astype(dt), vw)
        g = lax.dynamic_slice_in_dim(gates, q0, Q_CHUNK, 1)
        o_n = g[..., 0:1] * o_c + g[..., 1:2] * o_s + g[..., 2:3] * o_w
        return jnp.concatenate([o_m.reshape(B, Q_CHUNK, Hm * Dh),
                                o_n.reshape(B, Q_CHUNK, Hn * Dh)], axis=-1)

    outs = lax.map(chunk, jnp.arange(S // Q_CHUNK))
    o = outs.transpose(1, 0, 2, 3).reshape(B, S, Hm * Dh + Hn * Dh)
    return o @ w_out


def setup_inputs(seed: int = 0) -> dict:
    key = jax.random.key(seed)
    ks = jax.random.split(key, 20)
    nrm = lambda k, shape, s: jax.random.normal(k, shape, jnp.float32) * s
    col_scale = np.ones((PROJ_W,), np.float32)
    offs = np.concatenate([[0], np.cumsum(SPLIT_SIZES)])
    for vi in (2, 5, 7, 9):
        col_scale[offs[vi]:offs[vi + 1]] = DN_BETA
    return {
        "x": nrm(ks[0], (BATCH, SEQ, D_MODEL), 1.0),
        "p": nrm(ks[1], (DEPTH, BATCH, SEQ, D_PLE), 1.0),
        "w_in": nrm(ks[2], (DEPTH, D_MODEL, PROJ_W), D_MODEL ** -0.5) * jnp.asarray(col_scale),
        "cmp_pe_k": nrm(ks[3], (DEPTH, CMP_LEN, HEAD_DIM), 0.1),
        "cmp_w1_k": nrm(ks[4], (DEPTH, CMP_LEN, HEAD_DIM, HEAD_DIM), (CMP_LEN * HEAD_DIM) ** -0.5),
        "cmp_w2_k": nrm(ks[5], (DEPTH, HEAD_DIM, HEAD_DIM), HEAD_DIM ** -0.5),
        "cmp_pe_v": nrm(ks[6], (DEPTH, CMP_LEN, HEAD_DIM), 0.1),
        "cmp_w1_v": nrm(ks[7], (DEPTH, CMP_LEN, HEAD_DIM, HEAD_DIM), (CMP_LEN * HEAD_DIM) ** -0.5),
        "cmp_w2_v": nrm(ks[8], (DEPTH, HEAD_DIM, HEAD_DIM), HEAD_DIM ** -0.5),
        "rel_bias": nrm(ks[9], (N_BUCKETS, N_HEADS), 0.5),
        "w_out": nrm(ks[10], (DEPTH, D_MODEL, D_MODEL), D_MODEL ** -0.5 * DN_BETA),
        "ln1_g": 1.0 + nrm(ks[11], (DEPTH, D_MODEL), 0.01),
        "ln1_b": nrm(ks[12], (DEPTH, D_MODEL), 0.01),
        "w_ff1": nrm(ks[13], (DEPTH, D_MODEL, D_FF), D_MODEL ** -0.5),
        "w_ff2": nrm(ks[14], (DEPTH, D_FF, D_MODEL), D_FF ** -0.5 * DN_BETA),
        "w_ple": nrm(ks[15], (DEPTH, D_PLE, D_MODEL), D_PLE ** -0.5 * DN_BETA),
        "w_ple_gate": nrm(ks[16], (DEPTH, D_MODEL, D_MODEL), D_MODEL ** -0.5),
        "ln2_g": 1.0 + nrm(ks[17], (DEPTH, D_MODEL), 0.01),
        "ln2_b": nrm(ks[18], (DEPTH, D_MODEL), 0.01),
    }


def reference(x, p, w_in, cmp_pe_k, cmp_w1_k, cmp_w2_k, cmp_pe_v, cmp_w1_v, cmp_w2_v, rel_bias,
              w_out, ln1_g, ln1_b, w_ff1, w_ff2, w_ple, w_ple_gate, ln2_g, ln2_b):
    tab_flat = rel_bias.T.reshape(-1)
    h = x
    for i in range(DEPTH):
        a = hybrid_mixer(h, w_in[i], cmp_pe_k[i], cmp_w1_k[i], cmp_w2_k[i],
                         cmp_pe_v[i], cmp_w1_v[i], cmp_w2_v[i], tab_flat, w_out[i])
        h = layer_norm(DN_ALPHA * h + a, ln1_g[i], ln1_b[i])
        f = jnp.square(jax.nn.relu(h @ w_ff1[i])) @ w_ff2[i]
        e = jax.nn.sigmoid(h @ w_ple_gate[i]) * (p[i] @ w_ple[i])
        h = layer_norm(DN_ALPHA * h + f + e, ln2_g[i], ln2_b[i])
    return h
```

```cpp
#include <hip/hip_runtime.h>
#include <hip/hip_cooperative_groups.h>
#include <cstdio>
#include <cstdint>
namespace cg = cooperative_groups;
namespace pg8 {
#define PG8_LAS __attribute__((address_space(3)))
typedef unsigned short bf16_t;
typedef short bf16x8 __attribute__((ext_vector_type(8)));
typedef float f32x4 __attribute__((ext_vector_type(4)));
typedef unsigned u32x4 __attribute__((ext_vector_type(4)));
constexpr int BM = 256, BK = 64, HALF = 128, HTB = HALF * BK * 2  , STAGE_BYTES = 8 * HTB, NXCD = 8, WGM = 8;

__host__ __device__ __forceinline__ int lds_byte(int r, int c) { const int st = (r >> 4) * 2 + (c >> 5), rr = r & 15, cc = c & 31, ob = rr * 64 + cc * 2; return st * 1024 + (ob ^ (((ob >> 9) & 1) << 5)); }
__host__ __device__ __forceinline__ void stage_rc(int b, int& R, int& C) { const int st = b / 1024, sb = b % 1024, swz = sb ^ (((sb >> 9) & 1) << 5); R = (st >> 1) * 16 + swz / 64; C = (st & 1) * 32 + (swz % 64) / 2; }
__host__ __device__ __forceinline__ int perm32(int rho) { const int n = rho >> 4, i = rho & 15; return 8 * (i >> 2) + 4 * n + (i & 3); }

struct Unit { int pm, pn; };
struct Gemm { const bf16_t* A; const bf16_t* Bt; int M, N, K; };

struct StaticOrder {
    int nM, nN, nwg, G, c;
    __host__ __device__ void init(int M, int N, int G_, int c_) { nM = M / BM; nN = N / BM; nwg = nM * nN; G = G_; c = c_; }
    __host__ __device__ bool next(int i, Unit& u) const {
        const long L = (long)i * G + c; if (L >= nwg) return false;
        int wgid = (int)L; { const int q = nwg / NXCD, r = nwg % NXCD, xcd = wgid % NXCD, off = wgid / NXCD; wgid = (xcd < r ? xcd * (q + 1) : r * (q + 1) + (xcd - r) * q) + off; }
        const int nig = WGM * nN, gid = wgid / nig, fm = gid * WGM, gsz = (nM - fm) < WGM ? (nM - fm) : WGM;
        u.pm = fm + ((wgid % nig) % gsz); u.pn = (wgid % nig) / gsz; return true;
    }
    __device__ __forceinline__ void a_ready(const Unit&) const {}
    __device__ __forceinline__ void done(const Unit&) const {}
};

typedef float f32x2_t __attribute__((ext_vector_type(2))); typedef __bf16 bf16x2_t __attribute__((ext_vector_type(2)));
__device__ __forceinline__ unsigned cvt_pk_bf16(float lo, float hi) { f32x2_t v = {lo, hi}; bf16x2_t b = __builtin_convertvector(v, bf16x2_t); return __builtin_bit_cast(unsigned, b); }
__device__ __forceinline__ float bf_lo(unsigned w) { return __uint_as_float(w << 16); }
__device__ __forceinline__ float bf_hi(unsigned w) { return __uint_as_float(w & 0xffff0000u); }
template <int ACT> struct EpiBf16 {
    static constexpr bool PERM = true, AFTER_DRAIN = false;
    bf16_t* O; int ldc; int ncols;
    __device__ __forceinline__ void operator()(const f32x4 (&acc)[2][2][4][2], const Unit& u, int wr, int wc, int fr, int fq) const {
        const int row0 = u.pm * BM + wr * 64 + fr; const int col0 = u.pn * BM + wc * 32 + 8 * fq;
#pragma unroll
        for (int ai = 0; ai < 2; ++ai)
#pragma unroll
            for (int m = 0; m < 4; ++m) { bf16_t* rowp = O + (size_t)(row0 + ai * HALF + m * 16) * ldc + col0;
#pragma unroll
                for (int bj = 0; bj < 2; ++bj) { if (col0 + bj * HALF >= ncols) continue;
                    f32x4 v0 = acc[ai][bj][m][0], v1 = acc[ai][bj][m][1];
                    if (ACT == 1) {
#pragma unroll
                        for (int e = 0; e < 4; ++e) { const float a = fmaxf(v0[e], 0.f), b = fmaxf(v1[e], 0.f); v0[e] = a * a; v1[e] = b * b; } }
                    if (ACT == 2) {
#pragma unroll
                        for (int e = 0; e < 4; ++e) { v0[e] = __builtin_amdgcn_rcpf(1.f + __builtin_amdgcn_exp2f(-1.4426950408889634f * v0[e])); v1[e] = __builtin_amdgcn_rcpf(1.f + __builtin_amdgcn_exp2f(-1.4426950408889634f * v1[e])); } }
                    if (ACT == 3) { const u32x4 g = *(const u32x4*)(rowp + bj * HALF);
                        v0[0] *= bf_lo(g.x); v0[1] *= bf_hi(g.x); v0[2] *= bf_lo(g.y); v0[3] *= bf_hi(g.y); v1[0] *= bf_lo(g.z); v1[1] *= bf_hi(g.z); v1[2] *= bf_lo(g.w); v1[3] *= bf_hi(g.w); }
                    u32x4 w; w.x = cvt_pk_bf16(v0[0], v0[1]); w.y = cvt_pk_bf16(v0[2], v0[3]); w.z = cvt_pk_bf16(v1[0], v1[1]); w.w = cvt_pk_bf16(v1[2], v1[3]);
                    *(u32x4*)(rowp + bj * HALF) = w; }
                if (ACT == 3) asm volatile("" ::: "memory"); }
    }
};
struct EpiResid {
    static constexpr bool PERM = false, AFTER_DRAIN = false;
    const float* X; float* out; int ldc; float alpha;
    __device__ __forceinline__ void operator()(const f32x4 (&acc)[2][2][4][2], const Unit& u, int wr, int wc, int fr, int fq) const {
        const int row0 = u.pm * BM + wr * 64 + fr, col0 = u.pn * BM + wc * 32 + 4 * fq;
#pragma unroll
        for (int ai = 0; ai < 2; ++ai)
#pragma unroll
            for (int m = 0; m < 4; ++m) { const size_t off = (size_t)(row0 + ai * HALF + m * 16) * ldc + col0;
#pragma unroll
                for (int bj = 0; bj < 2; ++bj)
#pragma unroll
                    for (int n = 0; n < 2; ++n) { const f32x4 xv = *(const f32x4*)(X + off + bj * HALF + n * 16); *(f32x4*)(out + off + bj * HALF + n * 16) = xv * alpha + acc[ai][bj][m][n]; } }
    }
};
struct EpiFfn2 {
    static constexpr bool PERM = false, AFTER_DRAIN = false;
    float* out; const bf16_t* E; int ldc;
    __device__ __forceinline__ void operator()(const f32x4 (&acc)[2][2][4][2], const Unit& u, int wr, int wc, int fr, int fq) const {
        typedef unsigned u32x2 __attribute__((ext_vector_type(2)));
        const int row0 = u.pm * BM + wr * 64 + fr, col0 = u.pn * BM + wc * 32 + 4 * fq;
#pragma unroll
        for (int ai = 0; ai < 2; ++ai)
#pragma unroll
            for (int m = 0; m < 4; ++m) { const size_t off = (size_t)(row0 + ai * HALF + m * 16) * ldc + col0;
#pragma unroll
                for (int bj = 0; bj < 2; ++bj)
#pragma unroll
                    for (int n = 0; n < 2; ++n) { const f32x4 xv = *(const f32x4*)(out + off + bj * HALF + n * 16); const u32x2 ev = *(const u32x2*)(E + off + bj * HALF + n * 16);
                        f32x4 o = xv + acc[ai][bj][m][n]; o[0] += bf_lo(ev.x); o[1] += bf_hi(ev.x); o[2] += bf_lo(ev.y); o[3] += bf_hi(ev.y);
                        *(f32x4*)(out + off + bj * HALF + n * 16) = o; } }
    }
};
template <class Epi, class Sched, bool ALIGN_EPI = false, bool SP2 = false>
__device__ __forceinline__ void gemm_phase(PG8_LAS unsigned char* lds, const Gemm g, const Sched& S, const Epi& E) {
    const int tid = threadIdx.x, wid = __builtin_amdgcn_readfirstlane(tid >> 6), lane = tid & 63, wr = wid >> 2, wc = wid & 3, fr = lane & 15, fq = lane >> 4;
    const int K = g.K, nt = K / BK;
    unsigned voffA[2], voffB[2];
#pragma unroll
    for (int i = 0; i < 2; ++i) { int R, C; stage_rc(tid * 16 + i * 8192, R, C); const int Rb = Epi::PERM ? ((R & ~31) + perm32(R & 31)) : R;
        voffA[i] = (unsigned)(R * K + C) * 2u; voffB[i] = (unsigned)(Rb * K + C) * 2u; }
    const size_t kstep = (size_t)(BK * 2);
    const size_t hstep = (size_t)HALF * K * 2;
    const size_t tstep = 2 * hstep;
    const unsigned ldsw = (unsigned)wid * 1024u;
    const int aoff = lds_byte(wr * 64 + fr, fq * 8), boff = lds_byte(wc * 32 + fr, fq * 8);
#define PG8_SA(b, h) (((b) * 2 + (h)) * HTB)
#define PG8_SB(b, h) ((4 + (b) * 2 + (h)) * HTB)
#define PG8_STAGE(bufoff, gbase, voff) do { _Pragma("unroll") for (int _i = 0; _i < 2; ++_i) \
        __builtin_amdgcn_global_load_lds((const unsigned*)((const char*)(gbase) + (voff)[_i]), (PG8_LAS unsigned*)(lds + (bufoff) + ldsw + _i * 8192), 16, 0, 0); } while (0)
#define PG8_LDA(dst, b, h) do { _Pragma("unroll") for (int m = 0; m < 4; ++m) _Pragma("unroll") for (int k = 0; k < 2; ++k) dst[m][k] = *(const PG8_LAS bf16x8*)(lds + PG8_SA(b, h) + aoff + m * 2048 + k * 1024); } while (0)
#define PG8_LDB(dst, b, h) do { _Pragma("unroll") for (int n = 0; n < 2; ++n) _Pragma("unroll") for (int k = 0; k < 2; ++k) dst[n][k] = *(const PG8_LAS bf16x8*)(lds + PG8_SB(b, h) + boff + n * 2048 + k * 1024); } while (0)
#define PG8_MMA(ai, bj, At, Bt) do { __builtin_amdgcn_s_setprio(1); _Pragma("unroll") for (int m = 0; m < 4; ++m) _Pragma("unroll") for (int n = 0; n < 2; ++n) _Pragma("unroll") for (int k = 0; k < 2; ++k) \
        acc[ai][bj][m][n] = __builtin_amdgcn_mfma_f32_16x16x32_bf16(Bt[n][k], At[m][k], acc[ai][bj][m][n], 0, 0, 0); __builtin_amdgcn_s_setprio(0); } while (0)
#define PG8_WAIT_V(n) asm volatile("s_waitcnt vmcnt(" #n ")" ::: "memory")
#define PG8_WAIT_L(n) asm volatile("s_waitcnt lgkmcnt(" #n ")" ::: "memory")
#define PG8_BAR __builtin_amdgcn_s_barrier()
#define PG8_SCHED __builtin_amdgcn_sched_barrier(0)
    Unit cur, nxt; int ui = 0;
    if (!S.next(0, cur)) return;
    f32x4 acc[2][2][4][2];
#pragma unroll
    for (int a = 0; a < 2; ++a)
#pragma unroll
        for (int b = 0; b < 2; ++b)
#pragma unroll
            for (int m = 0; m < 4; ++m)
#pragma unroll
                for (int n = 0; n < 2; ++n) acc[a][b][m][n] = (f32x4){0.f, 0.f, 0.f, 0.f};
    bf16x8 At[4][2], B0[2][2], B1[2][2];
    const char* cA = (const char*)g.A + (size_t)cur.pm * tstep; const char* cB = (const char*)g.Bt + (size_t)cur.pn * tstep;
    S.a_ready(cur);
    if constexpr (SP2) {
        PG8_STAGE(PG8_SB(0, 0), cB, voffB); PG8_STAGE(PG8_SB(0, 1), cB + hstep, voffB); PG8_STAGE(PG8_SA(0, 0), cA, voffA); PG8_STAGE(PG8_SA(0, 1), cA + hstep, voffA);
        if (wr == 1) PG8_BAR;
        PG8_WAIT_V(2); PG8_BAR;
        PG8_STAGE(PG8_SB(1, 0), cB + kstep, voffB); PG8_STAGE(PG8_SA(1, 0), cA + kstep, voffA); PG8_STAGE(PG8_SB(1, 1), cB + hstep + kstep, voffB);
        PG8_WAIT_V(6); PG8_BAR;
    } else {
        PG8_STAGE(PG8_SB(0, 0), cB, voffB); PG8_STAGE(PG8_SA(0, 0), cA, voffA); PG8_STAGE(PG8_SB(0, 1), cB + hstep, voffB); PG8_STAGE(PG8_SA(0, 1), cA + hstep, voffA);
        if (wr == 1) PG8_BAR;
        PG8_WAIT_V(4); PG8_BAR;
        PG8_STAGE(PG8_SB(1, 0), cB + kstep, voffB); PG8_STAGE(PG8_SA(1, 0), cA + kstep, voffA); PG8_STAGE(PG8_SB(1, 1), cB + hstep + kstep, voffB);
        PG8_WAIT_V(6); PG8_BAR;
    }
    for (;;) {
        const bool has_next = S.next(ui + 1, nxt);
        const char* nA = has_next ? (const char*)g.A + (size_t)nxt.pm * tstep : cA; const char* nB = has_next ? (const char*)g.Bt + (size_t)nxt.pn * tstep : cB;
        for (int t = 0; t < nt; t += 2) {
            const bool last = (t == nt - 2);
            const char* a1 = cA + (size_t)(t + 1) * kstep;
            const char* a2 = last ? nA : cA + (size_t)(t + 2) * kstep; const char* b2 = last ? nB : cB + (size_t)(t + 2) * kstep;
            const char* a3 = a2 + kstep; const char* b3 = b2 + kstep;
            if (last && has_next) S.a_ready(nxt);
            if constexpr (SP2) {
            PG8_LDB(B0, 0, 0); PG8_LDB(B1, 0, 1); PG8_SCHED; PG8_LDA(At, 0, 0); PG8_STAGE(PG8_SA(1, 1), a1 + hstep, voffA);
            PG8_WAIT_V(8); PG8_WAIT_L(0); PG8_BAR; PG8_MMA(0, 0, At, B0); PG8_MMA(0, 1, At, B1); PG8_BAR; PG8_SCHED;
            PG8_LDA(At, 0, 1); PG8_STAGE(PG8_SB(0, 0), b2, voffB); PG8_STAGE(PG8_SB(0, 1), b2 + hstep, voffB); PG8_STAGE(PG8_SA(0, 0), a2, voffA);
            PG8_WAIT_V(8); PG8_WAIT_L(0); PG8_BAR; PG8_MMA(1, 0, At, B0); PG8_MMA(1, 1, At, B1); PG8_BAR; PG8_SCHED;
            PG8_LDB(B0, 1, 0); PG8_LDB(B1, 1, 1); PG8_SCHED; PG8_LDA(At, 1, 0); PG8_STAGE(PG8_SA(0, 1), a2 + hstep, voffA);
            PG8_WAIT_V(8); PG8_WAIT_L(0); PG8_BAR; PG8_MMA(0, 0, At, B0); PG8_MMA(0, 1, At, B1); PG8_BAR; PG8_SCHED;
            PG8_LDA(At, 1, 1); PG8_STAGE(PG8_SB(1, 0), b3, voffB); PG8_STAGE(PG8_SB(1, 1), b3 + hstep, voffB); PG8_STAGE(PG8_SA(1, 0), a3, voffA);
            PG8_WAIT_V(8); PG8_WAIT_L(0); PG8_BAR; PG8_MMA(1, 0, At, B0); PG8_MMA(1, 1, At, B1); PG8_BAR; PG8_SCHED;
            } else {
            PG8_LDB(B0, 0, 0); PG8_SCHED; PG8_LDA(At, 0, 0); PG8_STAGE(PG8_SA(1, 1), a1 + hstep, voffA);
            PG8_WAIT_L(8); PG8_BAR; PG8_WAIT_L(0); PG8_MMA(0, 0, At, B0); PG8_BAR; PG8_SCHED;
            PG8_LDB(B1, 0, 1); PG8_STAGE(PG8_SB(0, 0), b2, voffB);
            PG8_BAR; PG8_WAIT_L(0); PG8_MMA(0, 1, At, B1); PG8_BAR;
            PG8_LDA(At, 0, 1); PG8_STAGE(PG8_SA(0, 0), a2, voffA);
            PG8_BAR; PG8_WAIT_L(0); PG8_MMA(1, 0, At, B0); PG8_BAR; PG8_SCHED;
            PG8_STAGE(PG8_SB(0, 1), b2 + hstep, voffB);
            PG8_WAIT_V(6); PG8_BAR; PG8_MMA(1, 1, At, B1); PG8_BAR;
            PG8_LDB(B0, 1, 0); PG8_SCHED; PG8_LDA(At, 1, 0); PG8_STAGE(PG8_SA(0, 1), a2 + hstep, voffA);
            PG8_WAIT_L(8); PG8_BAR; PG8_WAIT_L(0); PG8_MMA(0, 0, At, B0); PG8_BAR; PG8_SCHED;
            PG8_LDB(B1, 1, 1); PG8_STAGE(PG8_SB(1, 0), b3, voffB);
            PG8_BAR; PG8_WAIT_L(0); PG8_MMA(0, 1, At, B1); PG8_BAR;
            PG8_LDA(At, 1, 1); PG8_STAGE(PG8_SA(1, 0), a3, voffA);
            PG8_BAR; PG8_WAIT_L(0); PG8_MMA(1, 0, At, B0); PG8_BAR; PG8_SCHED;
            PG8_STAGE(PG8_SB(1, 1), b3 + hstep, voffB);
            PG8_WAIT_V(6); PG8_BAR; PG8_MMA(1, 1, At, B1); PG8_BAR;
            }
        }
        if constexpr (ALIGN_EPI) { if (wr == 0) PG8_BAR; }
        if constexpr (!Epi::AFTER_DRAIN) { E(acc, cur, wr, wc, fr, fq); S.done(cur); }
        if (!has_next) break;
#pragma unroll
        for (int a = 0; a < 2; ++a)
#pragma unroll
            for (int b = 0; b < 2; ++b)
#pragma unroll
                for (int m = 0; m < 4; ++m)
#pragma unroll
                    for (int n = 0; n < 2; ++n) acc[a][b][m][n] = (f32x4){0.f, 0.f, 0.f, 0.f};
        cur = nxt; cA = nA; cB = nB; ++ui;
        if constexpr (ALIGN_EPI) { if (wr == 1) PG8_BAR; }
    }
    PG8_WAIT_V(0);
    if constexpr (!ALIGN_EPI) { if (wr == 0) PG8_BAR; }
    PG8_BAR;
    if constexpr (Epi::AFTER_DRAIN) { E.fused(acc, cur, wr, wc, fr, fq, lds, wid, lane); S.done(cur); }
#undef PG8_SA
#undef PG8_SB
#undef PG8_STAGE
#undef PG8_LDA
#undef PG8_LDB
#undef PG8_MMA
#undef PG8_WAIT_V
#undef PG8_WAIT_L
#undef PG8_BAR
#undef PG8_SCHED
}
}
constexpr int S_ = 8192, DM = 2048, DFF = 8192, DPLE = 256, PROJ = 5656, PROJ_PAD = 5888, ZP = PROJ;
constexpr int MQ_OFF = 0, MK_OFF = 1024, MV_OFF = 2048, NQ_OFF = 3072, CK_OFF = 4096, CV_OFF = 4352, SK_OFF = 4608, SV_OFF = 4864, WK_OFF = 5120, WV_OFF = 5376, GL_OFF = 5632;
constexpr float LN_EPS = 1e-5f;
constexpr float DN_ALPHA = 1.189207115002721f;
constexpr int NWAVES = 8;
constexpr size_t MiB = 1u << 20;
constexpr size_t WS_CTL = 0;
constexpr size_t WS_LUT = 1 * MiB;
constexpr size_t WS_KMH = WS_LUT + 8192;
constexpr size_t WS_KML = WS_KMH + 65536;
constexpr size_t WS_KC  = WS_KML + 65536;
constexpr size_t WS_VCT = WS_KC + 262144;
constexpr size_t WS_SEL = WS_VCT + 262144;
constexpr size_t WS_W2T = WS_SEL + 262144;
constexpr size_t WS_CC  = WS_W2T + 65536;
constexpr size_t WS_WOUT = 2 * MiB, WS_WFF1 = 10 * MiB, WS_WFF2 = 42 * MiB, WS_WGATE = 74 * MiB, WS_WPLE = 82 * MiB;
constexpr size_t WS_PB = 83 * MiB;
constexpr size_t WS_A = 87 * MiB;
constexpr size_t WS_B = 119 * MiB;
constexpr size_t WS_W1T = WS_B + 23 * MiB;
constexpr size_t WS_C = 151 * MiB;
constexpr size_t WS_END = 279 * MiB;
static_assert(WS_CC + 1024 <= WS_WOUT && (size_t)S_ * ZP * 2 <= 128 * MiB, "ws map");
constexpr int RING_BYTES = 131072, LDS_BYTES = 147456;
#define GAS __attribute__((address_space(1)))
#define LAS __attribute__((address_space(3)))
typedef unsigned short bf16;
typedef unsigned v4u __attribute__((ext_vector_type(4)));
typedef float f32x4 __attribute__((ext_vector_type(4)));
__device__ __forceinline__ unsigned f2bf(float f) { unsigned u = __builtin_bit_cast(unsigned, f); return (u + 0x7fffu + ((u >> 16) & 1u)) >> 16; }
__device__ __forceinline__ unsigned pk2(float lo, float hi) { return f2bf(lo) | (f2bf(hi) << 16); }
#define LDS_WAIT() asm volatile("s_waitcnt lgkmcnt(0)" ::: "memory")
__device__ __forceinline__ float wave_sum(float v) {
#pragma unroll
    for (int o = 1; o < 64; o <<= 1) v += __shfl_xor(v, o);
    return v;
}
__device__ __forceinline__ void p0_transpose_item(const float* W, int K, int N, bf16* WT, LAS float* scr, int item, int lane) {
    const int nblk = (N + 31) / 32, kb = item / nblk, nb = item % nblk, k0 = 64 * kb, n0 = 32 * nb;
    const bool okl = (n0 + (lane & 31)) < N;
#pragma unroll 8
    for (int i = 0; i < 32; ++i) { const int kk = 2 * i + (lane >> 5); scr[kk * 33 + (lane & 31)] = okl ? W[(size_t)(k0 + kk) * N + n0 + (lane & 31)] : 0.f; }
    LDS_WAIT(); asm volatile("" ::: "memory");
    const int c = lane & 7;
#pragma unroll
    for (int j = 0; j < 4; ++j) { const int n = (lane >> 3) + 8 * j; const LAS float* s = scr + (8 * c) * 33 + n;
        v4u o; o.x = pk2(s[0 * 33], s[1 * 33]); o.y = pk2(s[2 * 33], s[3 * 33]); o.z = pk2(s[4 * 33], s[5 * 33]); o.w = pk2(s[6 * 33], s[7 * 33]);
        if (n0 + n < N) *(GAS v4u*)(WT + (size_t)(n0 + n) * K + k0 + 8 * c) = o; }
    LDS_WAIT(); asm volatile("" ::: "memory");
}
__device__ __forceinline__ int t5_bucket(int n) {
    if (n < 16) return n;
    int b = 16;
    b += (n >= 19); b += (n >= 21); b += (n >= 24); b += (n >= 27); b += (n >= 31); b += (n >= 35); b += (n >= 40); b += (n >= 46);
    b += (n >= 52); b += (n >= 59); b += (n >= 67); b += (n >= 77); b += (n >= 87); b += (n >= 99); b += (n >= 113);
    return b;
}
struct Args { const float* in[19]; float* out; unsigned char* ws; int ph_lo, ph_hi; };
struct Frame {
    LAS unsigned char* lds; int tid, lane, wave, G, gw, NGW;
};
__device__ __forceinline__ void cvt_rows(const float* src, bf16* dst, size_t n8, int gt, int NGT) {
    for (size_t i = gt; i < n8; i += NGT) { const f32x4 a = *(const GAS f32x4*)(src + i * 8), b = *(const GAS f32x4*)(src + i * 8 + 4);
        v4u o; o.x = pk2(a[0], a[1]); o.y = pk2(a[2], a[3]); o.z = pk2(b[0], b[1]); o.w = pk2(b[2], b[3]); *(GAS v4u*)(dst + i * 8) = o; }
}
__device__ __forceinline__ void mx_cmp_const(const Frame& F, const float* pe, const float* w1, float* cc) {
    LAS float* red = (LAS float*)F.lds;
    const int e = F.tid & 127, part = F.tid >> 7; float s = 0.f;
    for (int k = part * 1024; k < part * 1024 + 1024; ++k) s += pe[k] * w1[(size_t)k * 128 + e];
    red[part * 128 + e] = s; __syncthreads();
    if (F.tid < 128) cc[F.tid] = (red[F.tid] + red[128 + F.tid]) + (red[256 + F.tid] + red[384 + F.tid]);
    __syncthreads();
}
__device__ __forceinline__ void p0_prologue(const Frame& F, const Args& a) {
    LAS float* scr = (LAS float*)(F.lds + F.wave * 16384);
    unsigned char* ws = a.ws;
    int base = 0;
#define TJOB(W_, K_, N_, WT_) do { const int nitems_ = ((K_) / 64) * (((N_) + 31) / 32); const int first_ = (F.gw - base % F.NGW + F.NGW) % F.NGW; \
        for (int it = first_; it < nitems_; it += F.NGW) p0_transpose_item((W_), (K_), (N_), (WT_), scr, it, F.lane); base += nitems_; } while (0)
    TJOB(a.in[2], DM, PROJ, (bf16*)(ws + WS_B));
    TJOB(a.in[10], DM, DM, (bf16*)(ws + WS_WOUT));
    TJOB(a.in[13], DM, DFF, (bf16*)(ws + WS_WFF1));
    TJOB(a.in[14], DFF, DM, (bf16*)(ws + WS_WFF2));
    TJOB(a.in[16], DM, DM, (bf16*)(ws + WS_WGATE));
    TJOB(a.in[15], DPLE, DM, (bf16*)(ws + WS_WPLE));
    TJOB(a.in[4], 4096, 128, (bf16*)(ws + WS_W1T));
    TJOB(a.in[7], 4096, 128, (bf16*)(ws + WS_W1T) + 128 * 4096);
    TJOB(a.in[5], 128, 128, (bf16*)(ws + WS_W2T));
    TJOB(a.in[8], 128, 128, (bf16*)(ws + WS_W2T) + 128 * 128);
#undef TJOB
    const int gt = F.gw * 64 + F.lane, NGT = F.NGW * 64;
    cvt_rows(a.in[0], (bf16*)(ws + WS_A), (size_t)S_ * DM / 8, gt, NGT);
    cvt_rows(a.in[1], (bf16*)(ws + WS_PB), (size_t)S_ * DPLE / 8, gt, NGT);
    __syncthreads();
    if ((int)blockIdx.x == F.G - 1) mx_cmp_const(F, a.in[3], a.in[4], (float*)(ws + WS_CC));
    if ((int)blockIdx.x == F.G - 2 || F.G == 1) mx_cmp_const(F, a.in[6], a.in[7], (float*)(ws + WS_CC) + 128);
    if (blockIdx.x == 0) {
        float* lut = (float*)(ws + WS_LUT); const float* rb = a.in[9];
        for (int i = F.tid; i < 16 * 128; i += 512) { const int h = i >> 7, d = i & 127; lut[i] = (rb[t5_bucket(d) * 16 + h] - rb[31 * 16 + h]) * 11.313708498984761f; }
    }
}
template <bool FIRST> __device__ __forceinline__ void ln_rows(const Frame& F, float* io, bf16* hb, const float* g, const float* b) {
    for (int m = F.gw; m < S_; m += F.NGW) {
        GAS f32x4* xr = (GAS f32x4*)(io + (size_t)m * DM) + F.lane;
        f32x4 v[8]; float s = 0.f;
#pragma unroll
        for (int j = 0; j < 8; ++j) { v[j] = xr[64 * j]; s += (v[j][0] + v[j][1]) + (v[j][2] + v[j][3]); }
        const float mean = wave_sum(s) * (1.f / DM); float s2 = 0.f;
#pragma unroll
        for (int j = 0; j < 8; ++j) { v[j] = v[j] - mean; s2 += (v[j][0] * v[j][0] + v[j][1] * v[j][1]) + (v[j][2] * v[j][2] + v[j][3] * v[j][3]); }
        const float rstd = 1.f / sqrtf(wave_sum(s2) * (1.f / DM) + LN_EPS);
#pragma unroll
        for (int j = 0; j < 8; ++j) { const f32x4 gg = *((const GAS f32x4*)g + F.lane + 64 * j), bb = *((const GAS f32x4*)b + F.lane + 64 * j);
            const f32x4 o = v[j] * rstd * gg + bb;
            if (FIRST) { xr[64 * j] = o * DN_ALPHA; typedef unsigned u32x2 __attribute__((ext_vector_type(2))); u32x2 w; w.x = pk2(o[0], o[1]); w.y = pk2(o[2], o[3]);
                *((GAS u32x2*)(hb + (size_t)m * DM) + F.lane + 64 * j) = w; }
            else xr[64 * j] = o; }
    }
}
namespace mx {
typedef short bf16x8 __attribute__((ext_vector_type(8)));
typedef float f32x16 __attribute__((ext_vector_type(16)));
typedef unsigned u32x4 __attribute__((ext_vector_type(4)));
typedef float f32x2_t __attribute__((ext_vector_type(2))); typedef __bf16 bf16x2_t __attribute__((ext_vector_type(2)));
__device__ __forceinline__ unsigned cvtpk(float lo, float hi) { f32x2_t v = {lo, hi}; bf16x2_t b = __builtin_convertvector(v, bf16x2_t); return __builtin_bit_cast(unsigned, b); }
__device__ __forceinline__ bf16x8 pack8(f32x4 a, f32x4 b) { u32x4 w = {cvtpk(a[0], a[1]), cvtpk(a[2], a[3]), cvtpk(b[0], b[1]), cvtpk(b[2], b[3])}; return __builtin_bit_cast(bf16x8, w); }
__device__ __forceinline__ float bf2f(unsigned short h) { return __uint_as_float((unsigned)h << 16); }
__device__ __forceinline__ int crow(int r, int hi) { return (r & 3) + 8 * (r >> 2) + 4 * hi; }

__device__ __forceinline__ void kmean_item(const Frame& F, const bf16* z, int h, int j, bf16* kmh, bf16* kml) {
    LAS float* red = (LAS float*)F.lds;
    const int cgp = F.tid & 15, rg = F.tid >> 4; float a[8] = {0.f, 0.f, 0.f, 0.f, 0.f, 0.f, 0.f, 0.f};
#pragma unroll
    for (int i = 0; i < 8; ++i) { const v4u w = *(const GAS v4u*)(z + (size_t)(256 * j + rg * 8 + i) * ZP + MK_OFF + h * 128 + cgp * 8);
        a[0] += __uint_as_float(w.x << 16); a[1] += __uint_as_float(w.x & 0xffff0000u); a[2] += __uint_as_float(w.y << 16); a[3] += __uint_as_float(w.y & 0xffff0000u);
        a[4] += __uint_as_float(w.z << 16); a[5] += __uint_as_float(w.z & 0xffff0000u); a[6] += __uint_as_float(w.w << 16); a[7] += __uint_as_float(w.w & 0xffff0000u); }
#pragma unroll
    for (int i = 0; i < 8; ++i) red[rg * 128 + cgp * 8 + i] = a[i];
    __syncthreads();
    if (F.tid < 128) { float s = 0.f;
#pragma unroll 8
        for (int r = 0; r < 32; ++r) s += red[r * 128 + F.tid];
        s *= (1.f / 256.f); const unsigned hb = f2bf(s); const float hf = __uint_as_float(hb << 16);
        kmh[(h * 32 + j) * 128 + F.tid] = (bf16)hb; kml[(h * 32 + j) * 128 + F.tid] = (bf16)f2bf(s - hf); }
    __syncthreads();
}
__device__ __forceinline__ void compress_item(const Frame& F, const bf16* z, int col_off, const bf16* w1T, const bf16* w2T, const float* cc, int rgp, int kv, bf16* kc, bf16* vcT) {
    const int lane = F.lane, r32 = lane & 31, hi = lane >> 5, w = F.wave;
    const int rho = 32 * rgp + r32, n = rho >> 1, g = rho & 1; const int nn = n > 510 ? 510 : n;
    f32x16 acc[4];
#pragma unroll
    for (int eb = 0; eb < 4; ++eb) acc[eb] = f32x16{};
#pragma unroll 1
    for (int ll = 0; ll < 4; ++ll) { const int l = 4 * w + ll; const bf16* arow = z + (size_t)(16 * nn + l) * ZP + col_off + g * 128 + hi * 8;
#pragma unroll
        for (int dd = 0; dd < 8; ++dd) { const bf16x8 a = *(const GAS bf16x8*)(arow + dd * 16); const int k0 = l * 128 + dd * 16 + hi * 8;
#pragma unroll
            for (int eb = 0; eb < 4; ++eb) { const bf16x8 b = *(const GAS bf16x8*)(w1T + (size_t)(eb * 32 + r32) * 4096 + k0);
                acc[eb] = __builtin_amdgcn_mfma_f32_32x32x16_bf16(a, b, acc[eb], 0, 0, 0); } } }
    LAS float* part = (LAS float*)F.lds;
#pragma unroll
    for (int eb = 0; eb < 4; ++eb)
#pragma unroll
        for (int r = 0; r < 16; ++r) part[(w * 32 + crow(r, hi)) * 128 + eb * 32 + r32] = acc[eb][r];
    __syncthreads();
    for (int i = F.tid; i < 32 * 128; i += 512) { float s = cc[i & 127];
#pragma unroll
        for (int p = 0; p < 8; ++p) s += part[p * 4096 + i];
        const float y = 0.7978845608028654f * (s + 0.044715f * s * s * s); const float t = 1.f - 2.f / (1.f + __expf(2.f * y));
        part[i] = 0.5f * s * (1.f + t); }
    __syncthreads();
    if (w < 4) {
        f32x16 o = f32x16{};
#pragma unroll
        for (int kk = 0; kk < 8; ++kk) { const LAS float* hp = part + r32 * 128 + kk * 16 + hi * 8; const f32x4 x0 = *(const LAS f32x4*)hp, x1 = *(const LAS f32x4*)(hp + 4);
            const bf16x8 a = pack8(x0, x1); const bf16x8 b = *(const GAS bf16x8*)(w2T + (size_t)(w * 32 + r32) * 128 + kk * 16 + hi * 8);
            o = __builtin_amdgcn_mfma_f32_32x32x16_bf16(a, b, o, 0, 0, 0); }
#pragma unroll
        for (int r = 0; r < 16; ++r) { const int row = crow(r, hi), rr = 32 * rgp + row, n2 = rr >> 1, g2 = rr & 1, f = w * 32 + r32;
            const float v = n2 <= 510 ? o[r] : 0.f;
            if (kv == 0) kc[(size_t)(g2 * 512 + n2) * 128 + f] = (bf16)f2bf(v); else vcT[(size_t)(g2 * 128 + f) * 512 + n2] = (bf16)f2bf(v); }
    }
    __syncthreads();
}
__device__ __forceinline__ void mixer_pre_a(const Frame& F, const Args& a) {
    unsigned char* ws = a.ws; const bf16* z = (const bf16*)(ws + WS_C);
    for (int it = blockIdx.x; it < 64 + 256; it += F.G) {
        if (it < 64) { const int kv = it & 1, rgp = it >> 1;
            compress_item(F, z, kv ? CV_OFF : CK_OFF, (const bf16*)(ws + WS_W1T) + (size_t)kv * 128 * 4096, (const bf16*)(ws + WS_W2T) + kv * 128 * 128, (const float*)(ws + WS_CC) + kv * 128, rgp, kv, (bf16*)(ws + WS_KC), (bf16*)(ws + WS_VCT)); }
        else { const int k = it - 64; kmean_item(F, z, k & 7, k >> 3, (bf16*)(ws + WS_KMH), (bf16*)(ws + WS_KML)); }
    }
}
}
namespace mx {
constexpr float SM_SCALE = 0.08838834764831845f;
constexpr float C2 = 1.4426950408889634f * SM_SCALE;
constexpr int LUT_OFF = 131072;
#define PK4(P, B_, OUT) do { unsigned a0 = cvtpk(P[B_+0], P[B_+1]), a1 = cvtpk(P[B_+2], P[B_+3]);                          \
        unsigned b0 = cvtpk(P[B_+4], P[B_+5]), b1 = cvtpk(P[B_+6], P[B_+7]);                                             \
        auto r0 = __builtin_amdgcn_permlane32_swap(a0, b0, false, false); auto r1 = __builtin_amdgcn_permlane32_swap(a1, b1, false, false); \
        u32x4 w = {r0[0], r1[0], r0[1], r1[1]}; OUT = __builtin_bit_cast(bf16x8, w); } while (0)
__device__ __forceinline__ void load_lut(const Frame& F, const float* lut_g) {
    LAS float* lut = (LAS float*)(F.lds + LUT_OFF);
    for (int i = F.tid; i < 16 * 128; i += 512) lut[i] = lut_g[i];
    __syncthreads();
}
__device__ __forceinline__ void cmp_scores(f32x16& p0, f32x16& p1, const bf16* kcg, int tt, const bf16x8* qr, int r32, int hi, int t, const LAS float* lutp) {
    p0 = f32x16{}; p1 = f32x16{};
    const bf16* k0 = kcg + (size_t)(64 * tt + r32) * 128 + hi * 8;
#pragma unroll
    for (int d0 = 0; d0 < 8; ++d0) { const bf16x8 b0 = *(const GAS bf16x8*)(k0 + d0 * 16), b1 = *(const GAS bf16x8*)(k0 + 32 * 128 + d0 * 16);
        p0 = __builtin_amdgcn_mfma_f32_32x32x16_bf16(b0, qr[d0], p0, 0, 0, 0); p1 = __builtin_amdgcn_mfma_f32_32x32x16_bf16(b1, qr[d0], p1, 0, 0, 0); }
    const float NEG = -__builtin_inff();
    const int dq = t - 31 - 16 * (64 * tt + 4 * hi);
#pragma unroll
    for (int r = 0; r < 16; ++r) { const int c = (r & 3) + 8 * (r >> 2); const int d0 = dq - 16 * c, d1 = d0 - 16 * 32;
        const float b0 = lutp[min((unsigned)d0, 127u)], b1 = lutp[min((unsigned)d1, 127u)];
        p0[r] = d0 >= 0 ? p0[r] + b0 : NEG; p1[r] = d1 >= 0 ? p1[r] + b1 : NEG; }
}
__device__ __forceinline__ float hmax32(const f32x16& p0, const f32x16& p1) {
    float m = p0[0];
#pragma unroll
    for (int r = 1; r < 16; ++r) m = fmaxf(m, p0[r]);
#pragma unroll
    for (int r = 0; r < 16; ++r) m = fmaxf(m, p1[r]);
    auto rr = __builtin_amdgcn_permlane32_swap(__float_as_uint(m), __float_as_uint(m), false, false);
    return fmaxf(__uint_as_float(rr[0]), __uint_as_float(rr[1]));
}
__device__ __forceinline__ float hsum32(const f32x16& p0, const f32x16& p1) {
    float s = 0.f;
#pragma unroll
    for (int r = 0; r < 16; ++r) s += p0[r];
#pragma unroll
    for (int r = 0; r < 16; ++r) s += p1[r];
    auto rr = __builtin_amdgcn_permlane32_swap(__float_as_uint(s), __float_as_uint(s), false, false);
    return __uint_as_float(rr[0]) + __uint_as_float(rr[1]);
}
__device__ __forceinline__ void cmp_item(const Frame& F, const Args& a, int g, int tg) {
    unsigned char* ws = a.ws; const bf16* z = (const bf16*)(ws + WS_C);
    const bf16* kcg = (const bf16*)(ws + WS_KC) + (size_t)g * 512 * 128; const bf16* vcg = (const bf16*)(ws + WS_VCT) + (size_t)g * 128 * 512;
    float* On = (float*)(ws + WS_B); unsigned* sel = (unsigned*)(ws + WS_SEL);
    const int lane = F.lane, r32 = lane & 31, hi = lane >> 5, w = F.wave;
    const int t0 = 8 * tg, tl = r32 >> 2, hl = r32 & 3, t = t0 + tl;
    const LAS float* lutp = (const LAS float*)(F.lds + LUT_OFF) + (8 + 4 * g + hl) * 128;
    LAS float* impG = (LAS float*)(F.lds + w * 12288);
    LAS float* impL = impG + 1024;
    LAS float* wsc = impL + 8 * 136;
    for (int i = lane; i < 1024 + 8 * 136; i += 64) impG[i] = 0.f;
    bf16x8 qr[8];
    { const bf16* qp = z + (size_t)t * ZP + NQ_OFF + (4 * g + hl) * 128 + hi * 8;
#pragma unroll
      for (int d0 = 0; d0 < 8; ++d0) qr[d0] = *(const GAS bf16x8*)(qp + d0 * 16); }
    const int tmax = t0 + 7; const int nmaxw = tmax >= 31 ? (tmax - 31) >> 4 : -1; const int NT = nmaxw >= 0 ? (nmaxw >> 6) + 1 : 0;
    float m = -1e30f, l = 0.f;
    for (int tt = 0; tt < NT; ++tt) { f32x16 p0, p1; cmp_scores(p0, p1, kcg, tt, qr, r32, hi, t, lutp);
        const float pm = hmax32(p0, p1) * C2; const float mn = fmaxf(m, pm); const float al = __builtin_amdgcn_exp2f(m - mn); m = mn;
#pragma unroll
        for (int r = 0; r < 16; ++r) { p0[r] = __builtin_amdgcn_exp2f(fmaf(p0[r], C2, -mn)); p1[r] = __builtin_amdgcn_exp2f(fmaf(p1[r], C2, -mn)); }
        l = l * al + hsum32(p0, p1); }
    const float rl = l > 0.f ? 1.f / l : 0.f;
    f32x16 o[4] = {f32x16{}, f32x16{}, f32x16{}, f32x16{}};
    for (int tt = 0; tt < NT; ++tt) { f32x16 p0, p1; cmp_scores(p0, p1, kcg, tt, qr, r32, hi, t, lutp);
#pragma unroll
        for (int r = 0; r < 16; ++r) { p0[r] = __builtin_amdgcn_exp2f(fmaf(p0[r], C2, -m)) * rl; p1[r] = __builtin_amdgcn_exp2f(fmaf(p1[r], C2, -m)) * rl; }
#pragma unroll
        for (int a4 = 0; a4 < 4; ++a4) {
            float g0 = (p0[4 * a4] + p0[4 * a4 + 1]) + (p0[4 * a4 + 2] + p0[4 * a4 + 3]), g1 = (p1[4 * a4] + p1[4 * a4 + 1]) + (p1[4 * a4 + 2] + p1[4 * a4 + 3]);
            float e0 = p0[4 * a4 + 3], e1 = p1[4 * a4 + 3];
            g0 += __shfl_xor(g0, 1); g0 += __shfl_xor(g0, 2); g1 += __shfl_xor(g1, 1); g1 += __shfl_xor(g1, 2);
            e0 += __shfl_xor(e0, 1); e0 += __shfl_xor(e0, 2); e1 += __shfl_xor(e1, 1); e1 += __shfl_xor(e1, 2);
            if (hl == 0) { const int j0 = 16 * tt + 2 * a4 + hi; impG[tl * 128 + j0] = g0; impG[tl * 128 + j0 + 8] = g1; impL[tl * 136 + j0 + 1] = e0; impL[tl * 136 + j0 + 9] = e1; } }
        bf16x8 pa0, pa1, pa2, pa3; PK4(p0, 0, pa0); PK4(p0, 8, pa1); PK4(p1, 0, pa2); PK4(p1, 8, pa3);
#pragma unroll
        for (int d0 = 0; d0 < 4; ++d0) { const bf16* vp = vcg + (size_t)(d0 * 32 + r32) * 512 + 64 * tt + hi * 8;
            const bf16x8 v0 = *(const GAS bf16x8*)(vp), v1 = *(const GAS bf16x8*)(vp + 16), v2 = *(const GAS bf16x8*)(vp + 32), v3 = *(const GAS bf16x8*)(vp + 48);
            o[d0] = __builtin_amdgcn_mfma_f32_32x32x16_bf16(pa0, v0, o[d0], 0, 0, 0); o[d0] = __builtin_amdgcn_mfma_f32_32x32x16_bf16(pa1, v1, o[d0], 0, 0, 0);
            o[d0] = __builtin_amdgcn_mfma_f32_32x32x16_bf16(pa2, v2, o[d0], 0, 0, 0); o[d0] = __builtin_amdgcn_mfma_f32_32x32x16_bf16(pa3, v3, o[d0], 0, 0, 0); } }
    if (hi == 0) { const float gl = bf2f(z[(size_t)t * ZP + GL_OFF + g * 12 + hl * 3 + 0]); wsc[r32] = 1.f / (1.f + __expf(-gl)); }
    LDS_WAIT(); asm volatile("" ::: "memory");
#pragma unroll
    for (int r = 0; r < 16; ++r) { const int q = crow(r, hi); const float gt = wsc[q]; float* op = On + (size_t)(t0 + (q >> 2)) * 1024 + (4 * g + (q & 3)) * 128 + r32;
#pragma unroll
        for (int d0 = 0; d0 < 4; ++d0) op[d0 * 32] = o[d0][r] * gt; }
    LDS_WAIT(); asm volatile("" ::: "memory");
    const unsigned long long lt_mask = (1ull << lane) - 1ull;
#pragma unroll 1
    for (int k = 0; k < 8; ++k) { const int tk = t0 + k, cur = tk >> 6; unsigned long long s0, s1;
        if (cur <= 15) { s0 = (cur >= 63) ? ~0ull : ((2ull << cur) - 1ull); s1 = 0ull; }
        else {
            const int j0 = lane, j1 = lane + 64;
            const float v0 = impG[k * 128 + j0] + impL[k * 136 + j0], v1 = impG[k * 128 + j1] + impL[k * 136 + j1];
            const unsigned u0 = (j0 >= 1 && j0 <= cur - 2) ? __float_as_uint(v0) + 1u : 0u, u1 = (j1 <= cur - 2) ? __float_as_uint(v1) + 1u : 0u;
            unsigned T = 0u;
#pragma unroll 1
            for (int b = 30; b >= 0; --b) { const unsigned cand = T | (1u << b);
                const int cnt = __builtin_popcountll(__builtin_amdgcn_ballot_w64(u0 >= cand)) + __builtin_popcountll(__builtin_amdgcn_ballot_w64(u1 >= cand));
                if (cnt >= 13) T = cand; }
            const unsigned long long gt0 = __builtin_amdgcn_ballot_w64(u0 > T), gt1 = __builtin_amdgcn_ballot_w64(u1 > T);
            const unsigned long long eq0 = __builtin_amdgcn_ballot_w64(u0 == T), eq1 = __builtin_amdgcn_ballot_w64(u1 == T);
            const int need = 13 - __builtin_popcountll(gt0) - __builtin_popcountll(gt1);
            const int rk0 = __builtin_popcountll(eq0 & lt_mask), rk1 = __builtin_popcountll(eq0) + __builtin_popcountll(eq1 & lt_mask);
            const bool f0 = (j0 == 0) || (j0 == cur) || (j0 == cur - 1), f1 = (j1 == cur) || (j1 == cur - 1);
            s0 = __builtin_amdgcn_ballot_w64(f0 || u0 > T || (u0 == T && rk0 < need)); s1 = __builtin_amdgcn_ballot_w64(f1 || u1 > T || (u1 == T && rk1 < need));
        }
        if (lane == 0) { u32x4 wv = {(unsigned)s0, (unsigned)(s0 >> 32), (unsigned)s1, (unsigned)(s1 >> 32)}; *(GAS u32x4*)(sel + ((size_t)tk * 2 + g) * 4) = wv; } }
    LDS_WAIT(); asm volatile("" ::: "memory");
}
__device__ __forceinline__ void mixer_pre_b(const Frame& F, const Args& a) {
    load_lut(F, (const float*)(a.ws + WS_LUT));
    for (int it = F.gw; it < 2048; it += F.NGW) { const int g = it & 1, k = it >> 1; cmp_item(F, a, g, k); }
}
}
namespace mx {
constexpr int NW = 8, QBLK = 32, KVBLK = 64, HD = 128;
constexpr int SHM_V = KVBLK * HD * 2, SHM_K = KVBLK * HD * 2;
constexpr float THR = 8.f;
typedef short s16x4 __attribute__((ext_vector_type(4)));
#define KSWZ(row, colB) ((row) * 256 + ((colB) ^ (((row) & 7) << 4)))
#define SBAR() __builtin_amdgcn_sched_barrier(0)
__device__ __forceinline__ int v_st(int k, int c) { const int kk = (k & ~0xC) | ((k & 4) << 1) | ((k & 8) >> 1); return ((kk >> 3) * 4 + (c >> 5)) * 512 + ((kk & 7) * 32 + (c & 31)) * 2; }
__device__ __forceinline__ int v_rd_base(int lane) { return ((lane & 3) << 3) | (((lane >> 2) & 3) << 6) | (((lane >> 4) & 1) << 5) | (((lane >> 5) & 1) << 8); }
constexpr int v_rd_off(int d0, int ks, int half) { return d0 * 512 + ks * 4096 + half * 2048; }
enum { MODE_MOBA = 0, MODE_SLC = 1, MODE_WIN = 2 };
__device__ __forceinline__ void mask_tile(f32x16& p0, f32x16& p1, int dq, unsigned W, bool rowsel, const LAS float* lutp) {
    const float NEG = -__builtin_inff();
#pragma unroll
    for (int r4 = 0; r4 < 16; r4 += 4) {
#pragma unroll
        for (int r = r4; r < r4 + 4; ++r) { const int c = (r & 3) + 8 * (r >> 2); const int d0 = dq - c, d1 = dq - c - 32;
            const float b0 = lutp[min((unsigned)d0, 127u)], b1 = lutp[min((unsigned)d1, 127u)];
            p0[r] = (rowsel && (unsigned)d0 < W) ? p0[r] + b0 : NEG; p1[r] = (rowsel && (unsigned)d1 < W) ? p1[r] + b1 : NEG; }
        asm volatile("" ::: "memory"); }
}
__device__ __forceinline__ void mask_rows(f32x16& p0, f32x16& p1, bool rowsel) {
    const float NEG = -__builtin_inff();
#pragma unroll
    for (int r = 0; r < 16; ++r) { p0[r] = rowsel ? p0[r] : NEG; p1[r] = rowsel ? p1[r] : NEG; }
}
__device__ __forceinline__ void partialSM(f32x16& p0, f32x16& p1, float& m_reg, float& mn, float& alpha) {
    float pmax = p0[0];
#pragma unroll
    for (int r = 1; r < 16; ++r) pmax = fmaxf(pmax, p0[r]);
#pragma unroll
    for (int r = 0; r < 16; ++r) pmax = fmaxf(pmax, p1[r]);
    { auto rr = __builtin_amdgcn_permlane32_swap(__float_as_uint(pmax), __float_as_uint(pmax), false, false);
      pmax = fmaxf(__uint_as_float(rr[0]), __uint_as_float(rr[1])); }
    if (__builtin_expect(__all((pmax - m_reg) * SM_SCALE <= THR), 1)) { mn = m_reg; alpha = 1.f; }
    else { mn = fmaxf(m_reg, pmax); alpha = __builtin_amdgcn_exp2f((m_reg - mn) * C2); m_reg = mn; }
    const float mnL = -mn * C2;
#pragma unroll
    for (int r = 0; r < 16; ++r) p0[r] = fmaf(p0[r], C2, mnL);
#pragma unroll
    for (int r = 0; r < 16; ++r) p1[r] = fmaf(p1[r], C2, mnL);
#pragma unroll
    for (int r = 0; r < 16; ++r) p0[r] = __builtin_amdgcn_exp2f(p0[r]);
}
__device__ __forceinline__ void finishSM(f32x16& p0, f32x16& p1, float alpha, float& l_reg, bf16x8& pa0, bf16x8& pa1, bf16x8& pa2, bf16x8& pa3) {
#pragma unroll
    for (int r = 0; r < 16; ++r) p1[r] = __builtin_amdgcn_exp2f(p1[r]);
    float ps = 0;
#pragma unroll
    for (int r = 0; r < 16; ++r) ps += p0[r];
#pragma unroll
    for (int r = 0; r < 16; ++r) ps += p1[r];
    { auto rr = __builtin_amdgcn_permlane32_swap(__float_as_uint(ps), __float_as_uint(ps), false, false);
      ps = __uint_as_float(rr[0]) + __uint_as_float(rr[1]); }
    l_reg = l_reg * alpha + ps;
    PK4(p0, 0, pa0); PK4(p0, 8, pa1); PK4(p1, 0, pa2); PK4(p1, 8, pa3);
}
template <int KB>
__device__ __forceinline__ void qkt(f32x16& p0, f32x16& p1, const char* K_lds, int r32, int hi, const bf16x8* qr) {
    p0 = f32x16{}; p1 = f32x16{};
    const char* kb[4];
#pragma unroll
    for (int dd = 0; dd < 4; ++dd) kb[dd] = K_lds + KB * SHM_K + KSWZ(r32, (dd * 16 + hi * 8) * 2);
#pragma unroll
    for (int d0 = 0; d0 < 8; ++d0) { const char* a = kb[d0 & 3] + (d0 >> 2) * 128;
        bf16x8 b0 = *reinterpret_cast<const bf16x8*>(a);
        bf16x8 b1 = *reinterpret_cast<const bf16x8*>(a + 32 * 256);
        p0 = __builtin_amdgcn_mfma_f32_32x32x16_bf16(b0, qr[d0], p0, 0, 0, 0);
        p1 = __builtin_amdgcn_mfma_f32_32x32x16_bf16(b1, qr[d0], p1, 0, 0, 0); }
}
template <int VB>
__device__ __forceinline__ void pv_tile(f32x16* o, int vb0, bf16x8 pa0, bf16x8 pa1, bf16x8 pa2, bf16x8 pa3) {
#define TRRD(dst, off) asm volatile("ds_read_b64_tr_b16 %0, %1 offset:%2" : "=&v"(dst) : "v"(vb0), "i"(off) : "memory")
#define PV_D0(d0) do { s16x4 l0, l1, l2, l3, h0, h1, h2, h3; constexpr int b_ = VB * SHM_V + v_rd_off(d0, 0, 0); \
        TRRD(l0, b_); TRRD(h0, b_ + 2048); TRRD(l1, b_ + 4096); TRRD(h1, b_ + 6144); TRRD(l2, b_ + 8192); TRRD(h2, b_ + 10240); TRRD(l3, b_ + 12288); TRRD(h3, b_ + 14336); \
        asm volatile("s_waitcnt lgkmcnt(0)" ::: "memory"); SBAR(); \
        o[d0] = __builtin_amdgcn_mfma_f32_32x32x16_bf16(pa0, (bf16x8){l0[0], l0[1], l0[2], l0[3], h0[0], h0[1], h0[2], h0[3]}, o[d0], 0, 0, 0);   \
        o[d0] = __builtin_amdgcn_mfma_f32_32x32x16_bf16(pa1, (bf16x8){l1[0], l1[1], l1[2], l1[3], h1[0], h1[1], h1[2], h1[3]}, o[d0], 0, 0, 0);   \
        o[d0] = __builtin_amdgcn_mfma_f32_32x32x16_bf16(pa2, (bf16x8){l2[0], l2[1], l2[2], l2[3], h2[0], h2[1], h2[2], h2[3]}, o[d0], 0, 0, 0);   \
        o[d0] = __builtin_amdgcn_mfma_f32_32x32x16_bf16(pa3, (bf16x8){l3[0], l3[1], l3[2], l3[3], h3[0], h3[1], h3[2], h3[3]}, o[d0], 0, 0, 0); } while (0)
    PV_D0(0); PV_D0(1); PV_D0(2); PV_D0(3);
#undef PV_D0
#undef TRRD
}
struct Blk { int mode, hg, idx; };
__device__ __forceinline__ int blk_jlo(const Blk& b) { return b.mode == MODE_WIN ? (b.idx > 8 ? b.idx - 8 : 0) : 0; }
__device__ __forceinline__ int blk_jhi(const Blk& b) { return b.mode == MODE_MOBA ? 4 * (b.idx + 1) : b.idx + 1; }
__device__ __forceinline__ int blk_koff(const Blk& b) { return b.mode == MODE_MOBA ? MK_OFF + b.hg * 128 : (b.mode == MODE_SLC ? SK_OFF : WK_OFF) + b.hg * 128; }
__device__ __forceinline__ int blk_voff(const Blk& b) { return b.mode == MODE_MOBA ? MV_OFF + b.hg * 128 : (b.mode == MODE_SLC ? SV_OFF : WV_OFF) + b.hg * 128; }
__device__ __forceinline__ int blk_tok(const Blk& b, int wid, int r32) { return b.mode == MODE_MOBA ? 256 * b.idx + 32 * wid + r32 : 64 * b.idx + 8 * wid + (r32 >> 2); }
__device__ __forceinline__ int blk_qcol(const Blk& b, int r32) { return b.mode == MODE_MOBA ? MQ_OFF + b.hg * 128 : NQ_OFF + (4 * b.hg + (r32 & 3)) * 128; }
struct Seam { bf16x8 qr[8]; bf16x8 st_v0, st_v1, st_k0, st_k1; };
#define VMW() asm volatile("s_waitcnt vmcnt(0)" ::: "memory")
#define VMWN(n) asm volatile("s_waitcnt vmcnt(%0)" :: "i"(n) : "memory")
#define SLOAD_H(ko, vo, k0) do { const char* kb__ = (const char*)z + ((size_t)(k0) * ZP + (ko)) * 2; const char* vb__ = (const char*)z + ((size_t)(k0) * ZP + (vo)) * 2; \
                         S.st_v0 = *(const GAS bf16x8*)(vb__ + roff0); S.st_v1 = *(const GAS bf16x8*)(vb__ + roff1);              \
                         S.st_k0 = *(const GAS bf16x8*)(kb__ + roff0); S.st_k1 = *(const GAS bf16x8*)(kb__ + roff1); } while (0)
#define SWRITE_HK(bf) do { *(bf16x8*)(K_lds + (bf) * SHM_K + kws) = S.st_k0; *(bf16x8*)(K_lds + (bf) * SHM_K + kws + 32 * 256) = S.st_k1; } while (0)
#define SWRITE_HV(bf) do { *(bf16x8*)(V_lds + (bf) * SHM_V + vst0) = S.st_v0; *(bf16x8*)(V_lds + (bf) * SHM_V + vst1) = S.st_v1; } while (0)
#define SWRITE_H(bf) do { SWRITE_HV(bf); SWRITE_HK(bf); } while (0)
__device__ __forceinline__ void att_prime(const Blk& cur, const bf16* z, char* lds, Seam& S) {
    const int tid = threadIdx.x, wid = __builtin_amdgcn_readfirstlane(tid >> 6), lane = tid & 63, r32 = lane & 31, hi = lane >> 5;
    const int sr = tid >> 4, sc = (tid & 15) * 8, kws = KSWZ(sr, sc * 2); char* K_lds = lds + 2 * SHM_V;
    const int kb0 = blk_jlo(cur) * KVBLK; const int ko = blk_koff(cur), vo = blk_voff(cur);
    const unsigned roff0 = (unsigned)(sr * ZP + sc) * 2u, roff1 = roff0 + 32u * ZP * 2u;
    { const unsigned qoff = (unsigned)(blk_tok(cur, wid, r32) * ZP + blk_qcol(cur, r32) + hi * 8) * 2u;
#pragma unroll
      for (int d0 = 0; d0 < 8; ++d0) S.qr[d0] = *(const GAS bf16x8*)((const char*)z + qoff + d0 * 32); }
    SLOAD_H(ko, vo, kb0); VMW(); SWRITE_HK(0);
    __syncthreads();
}
__device__ __forceinline__ void att_block(const Blk& cur, const Blk& nxt, const Args& a, char* lds, Seam& S) {
    const int MODE = cur.mode;
    unsigned char* ws = a.ws; const bf16* z = (const bf16*)(ws + WS_C);
    const int tid = threadIdx.x, wid = __builtin_amdgcn_readfirstlane(tid >> 6), lane = tid & 63, r32 = lane & 31, hi = lane >> 5;
    const int j_lo = blk_jlo(cur), j_hi = blk_jhi(cur), NT = j_hi - j_lo;
    const int kbn = blk_jlo(nxt) * KVBLK; const int ko = blk_koff(cur), vo = blk_voff(cur), kon = blk_koff(nxt), von = blk_voff(nxt);
    const int qpos = blk_tok(cur, wid, r32);
    const int qlo = MODE == MODE_MOBA ? 256 * cur.idx + 32 * wid : 64 * cur.idx + 8 * wid, qhi = qlo + (MODE == MODE_MOBA ? 31 : 7);
    const int qm = qpos - 4 * hi;
    const unsigned W = MODE == MODE_WIN ? 512u : 0x7fffffffu; const int Wedge = MODE == MODE_WIN ? 512 : 0x40000000;
    const LAS float* lutp = (const LAS float*)((LAS unsigned char*)lds + LUT_OFF) + (MODE == MODE_MOBA ? cur.hg : 8 + 4 * cur.hg + (r32 & 3)) * 128;
    char* V_lds = lds; char* K_lds = lds + 2 * SHM_V;
    LAS float* wsf = (LAS float*)((LAS unsigned char*)lds + 2 * SHM_V + 2 * SHM_K) + wid * 64; LAS float* li_l = wsf; LAS float* al_l = wsf + 32;
    LAS float* li_h = li_l + 4 * hi; LAS float* al_h = al_l + 4 * hi; asm volatile("" : "+v"(li_h), "+v"(al_h));
    unsigned sw0 = 0u, sw1 = 0u, sw2 = 0u, sw3 = 0u;
    if (MODE == MODE_WIN) { sw0 = sw1 = sw2 = sw3 = 0xffffffffu; }
    if (MODE == MODE_SLC) { const u32x4 wv = *(const GAS u32x4*)((const unsigned*)(ws + WS_SEL) + ((size_t)qpos * 2 + cur.hg) * 4); sw0 = wv.x; sw1 = wv.y; sw2 = wv.z; sw3 = wv.w; }
    if (MODE == MODE_MOBA) {
        const int nb = cur.idx;
        unsigned bm = 1u << nb;
        if (nb > 0) {
            int lane_o = lane; asm volatile("" : "+v"(lane_o));
            const unsigned kmo = (unsigned)((cur.hg * 32 + (lane_o & 31)) * 128 + (lane_o >> 5) * 8) * 2u; const char* kmhb = (const char*)(ws + WS_KMH); const char* kmlb = (const char*)(ws + WS_KML);
            f32x16 gs = f32x16{};
#pragma unroll
            for (int d0 = 0; d0 < 8; ++d0) { const bf16x8 ah = *(const GAS bf16x8*)(kmhb + kmo + d0 * 32), al = *(const GAS bf16x8*)(kmlb + kmo + d0 * 32);
                gs = __builtin_amdgcn_mfma_f32_32x32x16_bf16(ah, S.qr[d0], gs, 0, 0, 0); gs = __builtin_amdgcn_mfma_f32_32x32x16_bf16(al, S.qr[d0], gs, 0, 0, 0); }
            float v[32];
#pragma unroll
            for (int r = 0; r < 16; ++r) { auto rr = __builtin_amdgcn_permlane32_swap(__float_as_uint(gs[r]), __float_as_uint(gs[r]), false, false);
                const float lo = __uint_as_float(rr[0]), hv = __uint_as_float(rr[1]);
                v[(r & 3) + 8 * (r >> 2)] = lo; v[(r & 3) + 8 * (r >> 2) + 4] = hv; }
            float b1 = -__builtin_inff(), b2 = b1, b3 = b1; int i1 = -1, i2 = -1, i3 = -1;
#pragma unroll
            for (int j = 0; j < 32; ++j) { const float x = j < nb ? v[j] : -__builtin_inff();
                if (x > b1) { b3 = b2; i3 = i2; b2 = b1; i2 = i1; b1 = x; i1 = j; } else if (x > b2) { b3 = b2; i3 = i2; b2 = x; i2 = j; } else if (x > b3) { b3 = x; i3 = j; } }
            if (i1 >= 0) bm |= 1u << i1; if (i2 >= 0) bm |= 1u << i2; if (i3 >= 0) bm |= 1u << i3;
        }
#define EXP8(x) ((((x) & 1u) * 0xfu) | ((((x) >> 1) & 1u) * 0xf0u) | ((((x) >> 2) & 1u) * 0xf00u) | ((((x) >> 3) & 1u) * 0xf000u) | ((((x) >> 4) & 1u) * 0xf0000u) | ((((x) >> 5) & 1u) * 0xf00000u) | ((((x) >> 6) & 1u) * 0xf000000u) | ((((x) >> 7) & 1u) * 0xf0000000u))
        sw0 = EXP8(bm & 0xffu); sw1 = EXP8((bm >> 8) & 0xffu); sw2 = EXP8((bm >> 16) & 0xffu); sw3 = EXP8((bm >> 24) & 0xffu);
#undef EXP8
    }
    float m_reg = -1e30f, l_reg = 0; f32x16 o[4] = {f32x16{}, f32x16{}, f32x16{}, f32x16{}};
    const int sr = tid >> 4, sc = (tid & 15) * 8, vst0 = v_st(sr, sc), vst1 = v_st(32 + sr, sc), kws = KSWZ(sr, sc * 2);
    const unsigned roff0 = (unsigned)(sr * ZP + sc) * 2u, roff1 = roff0 + 32u * ZP * 2u;
    const int vb0 = (int)(uintptr_t)V_lds + v_rd_base(lane);
#define RESC(a_) do { if (__any((a_) < 1.f)) { if (hi == 0) al_l[r32] = (a_); asm volatile("s_waitcnt lgkmcnt(0)" ::: "memory");              \
                     for (int r = 0; r < 16; ++r) { const float f_ = al_h[(r & 3) + 8 * (r >> 2)]; for (int d_ = 0; d_ < 4; ++d_) o[d_][r] *= f_; } } } while (0)
#define KBASE(t) ((j_lo + (t)) * KVBLK)
#define MASKT(P0_, P1_, t) do { const int kb_ = KBASE(t); const int jt_ = j_lo + (t);                                                  \
        const unsigned wsel_ = (jt_ < 64) ? ((jt_ < 32) ? sw0 : sw1) : ((jt_ < 96) ? sw2 : sw3); const bool rs_ = (wsel_ >> (jt_ & 31)) & 1u;   \
        if (kb_ + KVBLK - 1 > qlo - 113 || kb_ <= qhi - Wedge) mask_tile(P0_, P1_, qm - kb_, W, rs_, lutp);                                 \
        else if (!__all(rs_)) mask_rows(P0_, P1_, rs_); } while (0)
#define SEAM_K0() do { VMWN(8); SWRITE_HK(0); SBAR(); } while (0)
    f32x16 pA0, pA1, pB0, pB1; float mnA, mnB, alA, alB; bf16x8 pa0, pa1, pa2, pa3;
    SWRITE_HV(0); SBAR();
    if (NT > 1) { SLOAD_H(ko, vo, KBASE(1)); }
    SBAR(); qkt<0>(pA0, pA1, K_lds, r32, hi, S.qr);
    MASKT(pA0, pA1, 0); partialSM(pA0, pA1, m_reg, mnA, alA);
    if (NT > 1) { VMW(); SWRITE_H(1); }
    __syncthreads();
#define HALF_STEP(PX0, PX1, mnX, alX, PY0, PY1, alY, t, KB, VB, SB) do {                                                      \
        SBAR(); qkt<KB>(PX0, PX1, K_lds, r32, hi, S.qr);                                                                      \
        finishSM(PY0, PY1, alY, l_reg, pa0, pa1, pa2, pa3); SBAR();                                                           \
        if ((t) + 1 < NT) { SLOAD_H(ko, vo, KBASE((t) + 1)); SBAR(); }                                                        \
        pv_tile<VB>(o, vb0, pa0, pa1, pa2, pa3); MASKT(PX0, PX1, (t)); partialSM(PX0, PX1, m_reg, mnX, alX);                  \
        __syncthreads();                                                                                                      \
        if ((t) + 1 < NT) { VMW(); SWRITE_H(SB); }                                                                            \
        RESC(alX); __syncthreads(); } while (0)
    for (int t = 1; t + 1 < NT; t += 2) {
        HALF_STEP(pB0, pB1, mnB, alB, pA0, pA1, alA, t, 1, 0, 0);
        HALF_STEP(pA0, pA1, mnA, alA, pB0, pB1, alB, t + 1, 0, 1, 1);
    }
    const bool even = (NT & 1) == 0;
    if (even) { SBAR(); qkt<1>(pB0, pB1, K_lds, r32, hi, S.qr); SBAR(); }
    SLOAD_H(kon, von, kbn); SBAR();
    { const unsigned qoff = (unsigned)(blk_tok(nxt, wid, r32) * ZP + blk_qcol(nxt, r32) + hi * 8) * 2u;
#pragma unroll
      for (int d0 = 0; d0 < 8; ++d0) S.qr[d0] = *(const GAS bf16x8*)((const char*)z + qoff + d0 * 32); }
    SBAR();
    finishSM(pA0, pA1, alA, l_reg, pa0, pa1, pa2, pa3); SBAR();
    pv_tile<0>(o, vb0, pa0, pa1, pa2, pa3);
    if (even) { MASKT(pB0, pB1, NT - 1); partialSM(pB0, pB1, m_reg, mnB, alB); __syncthreads(); RESC(alB);
        finishSM(pB0, pB1, alB, l_reg, pa0, pa1, pa2, pa3); SBAR(); pv_tile<1>(o, vb0, pa0, pa1, pa2, pa3); }
    SBAR(); SEAM_K0();
    if (hi == 0) { float f = 1.f / l_reg;
        if (MODE != MODE_MOBA) { const float gl = bf2f(z[(size_t)qpos * ZP + GL_OFF + cur.hg * 12 + (r32 & 3) * 3 + (MODE == MODE_SLC ? 1 : 2)]); f *= 1.f / (1.f + __expf(-gl)); }
        li_l[r32] = f; }
    asm volatile("s_waitcnt lgkmcnt(0)" ::: "memory");
    bf16* ocat = (bf16*)(ws + WS_A); float* On = (float*)(ws + WS_B);
#pragma unroll
    for (int r = 0; r < 16; ++r) { const int orow = crow(r, hi); const float rl = li_h[(r & 3) + 8 * (r >> 2)];
        if (MODE == MODE_MOBA) { bf16* Ow = ocat + (size_t)(qlo + orow) * DM + cur.hg * 128;
#pragma unroll
            for (int d0 = 0; d0 < 4; ++d0) { const float v = o[d0][r] * rl; const float vn = __shfl_xor(v, 1);
                if ((r32 & 1) == 0) *(unsigned*)(Ow + d0 * 32 + r32) = cvtpk(v, vn); } }
        else { const int tok = qlo + (orow >> 2), hh = 4 * cur.hg + (orow & 3); float* Op = On + (size_t)tok * 1024 + hh * 128 + r32;
#pragma unroll
            for (int d0 = 0; d0 < 4; ++d0) { const float v = Op[d0 * 32] + o[d0][r] * rl;
                if (MODE == MODE_SLC) Op[d0 * 32] = v;
                else { bf16* Ow = ocat + (size_t)tok * DM + 1024 + hh * 128; const float vn = __shfl_xor(v, 1); if ((r32 & 1) == 0) *(unsigned*)(Ow + d0 * 32 + r32) = cvtpk(v, vn); } }
            asm volatile("" ::: "memory"); } }
    __syncthreads();
#undef RESC
#undef KBASE
#undef MASKT
#undef SEAM_K0
#undef HALF_STEP
}
__device__ __forceinline__ void att_dispatch(const Blk& cur, const Blk& nxt, const Args& a, char* lds, Seam& S) { att_block(cur, nxt, a, lds, S); }
__device__ __forceinline__ int item_nblk(int k) { return k < 128 ? 2 : 4; }
__device__ __forceinline__ Blk item_blk(int k, int i) {
    Blk b;
    if (k < 128) { b.mode = MODE_MOBA; b.hg = k & 7; const int s = k >> 3; b.idx = i == 0 ? s : 31 - s; }
    else { const int kk = k - 128, s = kk >> 1; b.hg = kk & 1; b.mode = (i & 1) ? MODE_WIN : MODE_SLC; b.idx = (i < 2) ? s : 127 - s; }
    return b;
}
__device__ __forceinline__ void mixer_att(const Frame& F, const Args& a) {
    char* lds = (char*)F.lds;
    load_lut(F, (const float*)(a.ws + WS_LUT));
    const bf16* z = (const bf16*)(a.ws + WS_C);
    int k = blockIdx.x; if (k >= 256) return;
    int i = 0; Blk cur = item_blk(k, 0); Seam S;
    att_prime(cur, z, lds, S);
    for (;;) {
        int kn = k, in = i + 1; bool last = false;
        if (in >= item_nblk(k)) { in = 0; kn = k + F.G; if (kn >= 256) last = true; }
        const Blk nxt = last ? cur : item_blk(kn, in);
        att_dispatch(cur, nxt, a, lds, S);
        if (last) break;
        cur = nxt; k = kn; i = in;
    }
}
}
#define MIXER_PRE_A() mx::mixer_pre_a(F, args)
#define MIXER_PRE_B() mx::mixer_pre_b(F, args)
#define MIXER_ATT() mx::mixer_att(F, args)
#ifndef N_LAUNCHES
#define N_LAUNCHES 1
#endif
constexpr int NPH = 10;
__global__ void __launch_bounds__(NWAVES * 64, 2) fwd_kernel(Args args) {
    extern __shared__ __attribute__((aligned(16))) unsigned char lds_raw[];
    Frame F; F.lds = (LAS unsigned char*)lds_raw; F.tid = threadIdx.x; F.lane = F.tid & 63; F.wave = __builtin_amdgcn_readfirstlane(F.tid >> 6);
    F.G = gridDim.x; F.gw = blockIdx.x * NWAVES + F.wave; F.NGW = F.G * NWAVES;
    unsigned char* ws = args.ws;
    const int lo = args.ph_lo, hi = args.ph_hi;
#ifndef PHMASK
#define PHMASK 0x3ff
#endif
#define IN(k) (((PHMASK >> (k)) & 1) && lo <= (k) && (k) < hi)
#if N_LAUNCHES == 1
    cg::grid_group grid = cg::this_grid();
#define SEAM(k) do { if (lo <= (k) && (k) + 1 < hi) { asm volatile("s_waitcnt vmcnt(0) lgkmcnt(0)" ::: "memory"); grid.sync(); __builtin_amdgcn_fence(__ATOMIC_ACQUIRE, "agent"); asm volatile("s_waitcnt vmcnt(0)" ::: "memory"); } } while (0)
#else
#define SEAM(k) do { } while (0)
#endif
    bf16* const Wt_in = (bf16*)(ws + WS_B); bf16* const xb = (bf16*)(ws + WS_A); bf16* const zb = (bf16*)(ws + WS_C);
    bf16* const ocat = (bf16*)(ws + WS_A); bf16* const GE = (bf16*)(ws + WS_A); bf16* const h1 = (bf16*)(ws + WS_B); bf16* const ub = (bf16*)(ws + WS_C);
    if (IN(0)) { p0_prologue(F, args); } SEAM(0);
    if (IN(1)) { pg8::Gemm g{xb, Wt_in, S_, PROJ_PAD, DM}; pg8::StaticOrder S; S.init(S_, PROJ_PAD, F.G, (int)blockIdx.x);
        pg8::EpiBf16<0> E{zb, ZP, PROJ}; pg8::gemm_phase<pg8::EpiBf16<0>, pg8::StaticOrder, true, true>(F.lds, g, S, E); } SEAM(1);
    if (IN(2)) { MIXER_PRE_A(); } SEAM(2);
    if (IN(3)) { MIXER_PRE_B(); } SEAM(3);
    if (IN(4)) { MIXER_ATT(); } SEAM(4);
    if (IN(5)) { pg8::Gemm g{ocat, (bf16*)(ws + WS_WOUT), S_, DM, DM}; pg8::StaticOrder S; S.init(S_, DM, F.G, (int)blockIdx.x);
        pg8::EpiResid E{args.in[0], args.out, DM, DN_ALPHA}; pg8::gemm_phase<pg8::EpiResid, pg8::StaticOrder, true, true>(F.lds, g, S, E); } SEAM(5);
    if (IN(6)) { ln_rows<true>(F, args.out, h1, args.in[11], args.in[12]); } SEAM(6);
    if (IN(7)) {
#ifndef NO6A
        { pg8::Gemm g{h1, (bf16*)(ws + WS_WFF1), S_, DFF, DM}; pg8::StaticOrder S; S.init(S_, DFF, F.G, (int)blockIdx.x);
          pg8::EpiBf16<1> E{ub, DFF, DFF}; pg8::gemm_phase<pg8::EpiBf16<1>, pg8::StaticOrder, true, true>(F.lds, g, S, E); }
#endif
#ifndef NO6B
        { pg8::Gemm g{h1, (bf16*)(ws + WS_WGATE), S_, DM, DM}; pg8::StaticOrder S; S.init(S_, DM, F.G, (int)blockIdx.x);
          pg8::EpiBf16<2> E{GE, DM, DM}; pg8::gemm_phase<pg8::EpiBf16<2>, pg8::StaticOrder, true, true>(F.lds, g, S, E); }
#endif
#ifndef NO6C
        asm volatile("s_waitcnt vmcnt(0)" ::: "memory"); __syncthreads();
        { int kple = DPLE; asm volatile("" : "+s"(kple)); pg8::Gemm g{(bf16*)(ws + WS_PB), (bf16*)(ws + WS_WPLE), S_, DM, kple}; pg8::StaticOrder S; S.init(S_, DM, F.G, (int)blockIdx.x);
          pg8::EpiBf16<3> E{GE, DM, DM}; pg8::gemm_phase<pg8::EpiBf16<3>, pg8::StaticOrder, true, true>(F.lds, g, S, E); }
#endif
    } SEAM(7);
    if (IN(8)) { pg8::Gemm g{ub, (bf16*)(ws + WS_WFF2), S_, DM, DFF}; pg8::StaticOrder S; S.init(S_, DM, F.G, (int)blockIdx.x);
        pg8::EpiFfn2 E{args.out, GE, DM}; pg8::gemm_phase<pg8::EpiFfn2, pg8::StaticOrder, true, true>(F.lds, g, S, E); } SEAM(8);
    if (IN(9)) { ln_rows<false>(F, args.out, nullptr, args.in[17], args.in[18]); }
#undef IN
#undef SEAM
}

extern "C" void kernel_launch(void* const* d_in, const int* in_sizes, int n_in, void* d_out, int out_size, void* d_ws, size_t ws_size, hipStream_t stream) {
    static int grid = 0;
    if (grid == 0) {
        if (n_in != 19 || out_size != S_ * DM || ws_size < WS_END) { fprintf(stderr, "kernel_launch: unexpected shapes (n_in %d out %d ws %zu)\n", n_in, out_size, ws_size); grid = -1; return; }
        int dev = 0, cus = 0, per_cu = 0;
        (void)hipGetDevice(&dev); (void)hipDeviceGetAttribute(&cus, hipDeviceAttributeMultiprocessorCount, dev);
        if (hipFuncSetAttribute((const void*)fwd_kernel, hipFuncAttributeMaxDynamicSharedMemorySize, LDS_BYTES) != hipSuccess) { fprintf(stderr, "kernel_launch: hipFuncSetAttribute failed\n"); grid = -1; return; }
        if (hipOccupancyMaxActiveBlocksPerMultiprocessor(&per_cu, (const void*)fwd_kernel, NWAVES * 64, LDS_BYTES) != hipSuccess || per_cu < 1) { fprintf(stderr, "kernel_launch: occupancy query gives %d\n", per_cu); per_cu = 1; }
        (void)hipGetLastError();
        grid = cus * 1;
        if (grid <= 0) grid = 256;
    }
    if (grid < 0) return;
    Args a{};
    for (int i = 0; i < 19; ++i) a.in[i] = (const float*)d_in[i];
    a.out = (float*)d_out; a.ws = (unsigned char*)d_ws;
#if N_LAUNCHES == 1
    a.ph_lo = 0; a.ph_hi = NPH;
    void* kargs[] = {&a};
    hipError_t e = hipLaunchCooperativeKernel((const void*)fwd_kernel, dim3(grid), dim3(NWAVES * 64), kargs, LDS_BYTES, stream);
    if (e != hipSuccess) fprintf(stderr, "cooperative launch failed: %s (grid %d)\n", hipGetErrorString(e), grid);
#else
    for (int p = 0; p < NPH; ++p) { a.ph_lo = p; a.ph_hi = p + 1; hipLaunchKernelGGL(fwd_kernel, dim3(grid), dim3(NWAVES * 64), LDS_BYTES, stream, a); }
#endif
}
```

```cpp
#include <hip/hip_runtime.h>
#include <hip/hip_cooperative_groups.h>
#include <cstdio>
#include <cstdint>
namespace cg = cooperative_groups;
namespace pg8 {
#define PG8_LAS __attribute__((address_space(3)))
typedef unsigned short bf16_t;
typedef short bf16x8 __attribute__((ext_vector_type(8)));
typedef float f32x4 __attribute__((ext_vector_type(4)));
typedef unsigned u32x4 __attribute__((ext_vector_type(4)));
constexpr int BM = 256, BK = 64, HALF = 128, HTB = HALF * BK * 2  , STAGE_BYTES = 8 * HTB, NXCD = 8, WGM = 8;

__host__ __device__ __forceinline__ int lds_byte(int r, int c) { const int st = (r >> 4) * 2 + (c >> 5), rr = r & 15, cc = c & 31, ob = rr * 64 + cc * 2; return st * 1024 + (ob ^ (((ob >> 9) & 1) << 5)); }
__host__ __device__ __forceinline__ void stage_rc(int b, int& R, int& C) { const int st = b / 1024, sb = b % 1024, swz = sb ^ (((sb >> 9) & 1) << 5); R = (st >> 1) * 16 + swz / 64; C = (st & 1) * 32 + (swz % 64) / 2; }
__host__ __device__ __forceinline__ int perm32(int rho) { const int n = rho >> 4, i = rho & 15; return 8 * (i >> 2) + 4 * n + (i & 3); }

struct Unit { int pm, pn; };
struct Gemm { const bf16_t* A; const bf16_t* Bt; int M, N, K; };

struct StaticOrder {
    int nM, nN, nwg, G, c;
    __host__ __device__ void init(int M, int N, int G_, int c_) { nM = M / BM; nN = N / BM; nwg = nM * nN; G = G_; c = c_; }
    __host__ __device__ bool next(int i, Unit& u) const {
        const long L = (long)i * G + c; if (L >= nwg) return false;
        int wgid = (int)L; { const int q = nwg / NXCD, r = nwg % NXCD, xcd = wgid % NXCD, off = wgid / NXCD; wgid = (xcd < r ? xcd * (q + 1) : r * (q + 1) + (xcd - r) * q) + off; }
        const int nig = WGM * nN, gid = wgid / nig, fm = gid * WGM, gsz = (nM - fm) < WGM ? (nM - fm) : WGM;
        u.pm = fm + ((wgid % nig) % gsz); u.pn = (wgid % nig) / gsz; return true;
    }
    __device__ __forceinline__ void a_ready(const Unit&) const {}
    __device__ __forceinline__ void done(const Unit&) const {}
};

typedef float f32x2_t __attribute__((ext_vector_type(2))); typedef __bf16 bf16x2_t __attribute__((ext_vector_type(2)));
__device__ __forceinline__ unsigned cvt_pk_bf16(float lo, float hi) { f32x2_t v = {lo, hi}; bf16x2_t b = __builtin_convertvector(v, bf16x2_t); return __builtin_bit_cast(unsigned, b); }
__device__ __forceinline__ float bf_lo(unsigned w) { return __uint_as_float(w << 16); }
__device__ __forceinline__ float bf_hi(unsigned w) { return __uint_as_float(w & 0xffff0000u); }
template <int ACT> struct EpiBf16 {
    static constexpr bool PERM = true, AFTER_DRAIN = false;
    bf16_t* O; int ldc; int ncols;
    __device__ __forceinline__ void operator()(const f32x4 (&acc)[2][2][4][2], const Unit& u, int wr, int wc, int fr, int fq) const {
        const int row0 = u.pm * BM + wr * 64 + fr; const int col0 = u.pn * BM + wc * 32 + 8 * fq;
#pragma unroll
        for (int ai = 0; ai < 2; ++ai)
#pragma unroll
            for (int m = 0; m < 4; ++m) { bf16_t* rowp = O + (size_t)(row0 + ai * HALF + m * 16) * ldc + col0;
#pragma unroll
                for (int bj = 0; bj < 2; ++bj) { if (col0 + bj * HALF >= ncols) continue;
                    f32x4 v0 = acc[ai][bj][m][0], v1 = acc[ai][bj][m][1];
                    if (ACT == 1) {
#pragma unroll
                        for (int e = 0; e < 4; ++e) { const float a = fmaxf(v0[e], 0.f), b = fmaxf(v1[e], 0.f); v0[e] = a * a; v1[e] = b * b; } }
                    if (ACT == 2) {
#pragma unroll
                        for (int e = 0; e < 4; ++e) { v0[e] = __builtin_amdgcn_rcpf(1.f + __builtin_amdgcn_exp2f(-1.4426950408889634f * v0[e])); v1[e] = __builtin_amdgcn_rcpf(1.f + __builtin_amdgcn_exp2f(-1.4426950408889634f * v1[e])); } }
                    if (ACT == 3) { const u32x4 g = *(const u32x4*)(rowp + bj * HALF);
                        v0[0] *= bf_lo(g.x); v0[1] *= bf_hi(g.x); v0[2] *= bf_lo(g.y); v0[3] *= bf_hi(g.y); v1[0] *= bf_lo(g.z); v1[1] *= bf_hi(g.z); v1[2] *= bf_lo(g.w); v1[3] *= bf_hi(g.w); }
                    u32x4 w; w.x = cvt_pk_bf16(v0[0], v0[1]); w.y = cvt_pk_bf16(v0[2], v0[3]); w.z = cvt_pk_bf16(v1[0], v1[1]); w.w = cvt_pk_bf16(v1[2], v1[3]);
                    *(u32x4*)(rowp + bj * HALF) = w; }
                if (ACT == 3) asm volatile("" ::: "memory"); }
    }
};
struct EpiResid {
    static constexpr bool PERM = false, AFTER_DRAIN = false;
    const float* X; float* out; int ldc; float alpha;
    __device__ __forceinline__ void operator()(const f32x4 (&acc)[2][2][4][2], const Unit& u, int wr, int wc, int fr, int fq) const {
        const int row0 = u.pm * BM + wr * 64 + fr, col0 = u.pn * BM + wc * 32 + 4 * fq;
#pragma unroll
        for (int ai = 0; ai < 2; ++ai)
#pragma unroll
            for (int m = 0; m < 4; ++m) { const size_t off = (size_t)(row0 + ai * HALF + m * 16) * ldc + col0;
#pragma unroll
                for (int bj = 0; bj < 2; ++bj)
#pragma unroll
                    for (int n = 0; n < 2; ++n) { const f32x4 xv = *(const f32x4*)(X + off + bj * HALF + n * 16); *(f32x4*)(out + off + bj * HALF + n * 16) = xv * alpha + acc[ai][bj][m][n]; } }
    }
};
struct EpiFfn2 {
    static constexpr bool PERM = false, AFTER_DRAIN = false;
    float* out; const bf16_t* E; int ldc;
    __device__ __forceinline__ void operator()(const f32x4 (&acc)[2][2][4][2], const Unit& u, int wr, int wc, int fr, int fq) const {
        typedef unsigned u32x2 __attribute__((ext_vector_type(2)));
        const int row0 = u.pm * BM + wr * 64 + fr, col0 = u.pn * BM + wc * 32 + 4 * fq;
#pragma unroll
        for (int ai = 0; ai < 2; ++ai)
#pragma unroll
            for (int m = 0; m < 4; ++m) { const size_t off = (size_t)(row0 + ai * HALF + m * 16) * ldc + col0;
#pragma unroll
                for (int bj = 0; bj < 2; ++bj)
#pragma unroll
                    for (int n = 0; n < 2; ++n) { const f32x4 xv = *(const f32x4*)(out + off + bj * HALF + n * 16); const u32x2 ev = *(const u32x2*)(E + off + bj * HALF + n * 16);
                        f32x4 o = xv + acc[ai][bj][m][n]; o[0] += bf_lo(ev.x); o[1] += bf_hi(ev.x); o[2] += bf_lo(ev.y); o[3] += bf_hi(ev.y);
                        *(f32x4*)(out + off + bj * HALF + n * 16) = o; } }
    }
};
template <class Epi, class Sched, bool ALIGN_EPI = false, bool SP2 = false>
__device__ __forceinline__ void gemm_phase(PG8_LAS unsigned char* lds, const Gemm g, const Sched& S, const Epi& E, const int tid_in) {
    const int tid = tid_in, wid = __builtin_amdgcn_readfirstlane(tid >> 6), lane = tid & 63, wr = wid >> 2, wc = wid & 3, fr = lane & 15, fq = lane >> 4;
    const int K = g.K, nt = K / BK;
    unsigned voffA[2], voffB[2];
#pragma unroll
    for (int i = 0; i < 2; ++i) { int R, C; stage_rc(tid * 16 + i * 8192, R, C); const int Rb = Epi::PERM ? ((R & ~31) + perm32(R & 31)) : R;
        voffA[i] = (unsigned)(R * K + C) * 2u; voffB[i] = (unsigned)(Rb * K + C) * 2u; }
    const size_t kstep = (size_t)(BK * 2);
    const size_t hstep = (size_t)HALF * K * 2;
    const size_t tstep = 2 * hstep;
    const unsigned ldsw = (unsigned)wid * 1024u;
    const int aoff = lds_byte(wr * 64 + fr, fq * 8), boff = lds_byte(wc * 32 + fr, fq * 8);
#define PG8_SA(b, h) (((b) * 2 + (h)) * HTB)
#define PG8_SB(b, h) ((4 + (b) * 2 + (h)) * HTB)
#define PG8_STAGE(bufoff, gbase, voff) do { _Pragma("unroll") for (int _i = 0; _i < 2; ++_i) \
        __builtin_amdgcn_global_load_lds((const unsigned*)((const char*)(gbase) + (voff)[_i]), (PG8_LAS unsigned*)(lds + (bufoff) + ldsw + _i * 8192), 16, 0, 0); } while (0)
#define PG8_LDA(dst, b, h) do { _Pragma("unroll") for (int m = 0; m < 4; ++m) _Pragma("unroll") for (int k = 0; k < 2; ++k) dst[m][k] = *(const PG8_LAS bf16x8*)(lds + PG8_SA(b, h) + aoff + m * 2048 + k * 1024); } while (0)
#define PG8_LDB(dst, b, h) do { _Pragma("unroll") for (int n = 0; n < 2; ++n) _Pragma("unroll") for (int k = 0; k < 2; ++k) dst[n][k] = *(const PG8_LAS bf16x8*)(lds + PG8_SB(b, h) + boff + n * 2048 + k * 1024); } while (0)
#define PG8_MMA(ai, bj, At, Bt) do { __builtin_amdgcn_s_setprio(1); _Pragma("unroll") for (int m = 0; m < 4; ++m) _Pragma("unroll") for (int n = 0; n < 2; ++n) _Pragma("unroll") for (int k = 0; k < 2; ++k) \
        acc[ai][bj][m][n] = __builtin_amdgcn_mfma_f32_16x16x32_bf16(Bt[n][k], At[m][k], acc[ai][bj][m][n], 0, 0, 0); __builtin_amdgcn_s_setprio(0); } while (0)
#define PG8_WAIT_V(n) asm volatile("s_waitcnt vmcnt(" #n ")" ::: "memory")
#define PG8_WAIT_L(n) asm volatile("s_waitcnt lgkmcnt(" #n ")" ::: "memory")
#define PG8_BAR __builtin_amdgcn_s_barrier()
#define PG8_SCHED __builtin_amdgcn_sched_barrier(0)
    Unit cur, nxt; int ui = 0;
    if (!S.next(0, cur)) return;
    f32x4 acc[2][2][4][2];
#pragma unroll
    for (int a = 0; a < 2; ++a)
#pragma unroll
        for (int b = 0; b < 2; ++b)
#pragma unroll
            for (int m = 0; m < 4; ++m)
#pragma unroll
                for (int n = 0; n < 2; ++n) acc[a][b][m][n] = (f32x4){0.f, 0.f, 0.f, 0.f};
    bf16x8 At[4][2], B0[2][2], B1[2][2];
    const char* cA = (const char*)g.A + (size_t)cur.pm * tstep; const char* cB = (const char*)g.Bt + (size_t)cur.pn * tstep;
    S.a_ready(cur);
    if constexpr (SP2) {
        PG8_STAGE(PG8_SB(0, 0), cB, voffB); PG8_STAGE(PG8_SB(0, 1), cB + hstep, voffB); PG8_STAGE(PG8_SA(0, 0), cA, voffA); PG8_STAGE(PG8_SA(0, 1), cA + hstep, voffA);
        if (wr == 1) PG8_BAR;
        PG8_WAIT_V(2); PG8_BAR;
        PG8_STAGE(PG8_SB(1, 0), cB + kstep, voffB); PG8_STAGE(PG8_SA(1, 0), cA + kstep, voffA); PG8_STAGE(PG8_SB(1, 1), cB + hstep + kstep, voffB);
        PG8_WAIT_V(6); PG8_BAR;
    } else {
        PG8_STAGE(PG8_SB(0, 0), cB, voffB); PG8_STAGE(PG8_SA(0, 0), cA, voffA); PG8_STAGE(PG8_SB(0, 1), cB + hstep, voffB); PG8_STAGE(PG8_SA(0, 1), cA + hstep, voffA);
        if (wr == 1) PG8_BAR;
        PG8_WAIT_V(4); PG8_BAR;
        PG8_STAGE(PG8_SB(1, 0), cB + kstep, voffB); PG8_STAGE(PG8_SA(1, 0), cA + kstep, voffA); PG8_STAGE(PG8_SB(1, 1), cB + hstep + kstep, voffB);
        PG8_WAIT_V(6); PG8_BAR;
    }
    for (;;) {
        const bool has_next = S.next(ui + 1, nxt);
        const char* nA = has_next ? (const char*)g.A + (size_t)nxt.pm * tstep : cA; const char* nB = has_next ? (const char*)g.Bt + (size_t)nxt.pn * tstep : cB;
        for (int t = 0; t < nt; t += 2) {
            const bool last = (t == nt - 2);
            const char* a1 = cA + (size_t)(t + 1) * kstep;
            const char* a2 = last ? nA : cA + (size_t)(t + 2) * kstep; const char* b2 = last ? nB : cB + (size_t)(t + 2) * kstep;
            const char* a3 = a2 + kstep; const char* b3 = b2 + kstep;
            if (last && has_next) S.a_ready(nxt);
            if constexpr (SP2) {
            PG8_LDB(B0, 0, 0); PG8_LDB(B1, 0, 1); PG8_SCHED; PG8_LDA(At, 0, 0); PG8_STAGE(PG8_SA(1, 1), a1 + hstep, voffA);
            PG8_WAIT_V(8); PG8_WAIT_L(0); PG8_BAR; PG8_MMA(0, 0, At, B0); PG8_MMA(0, 1, At, B1); PG8_BAR; PG8_SCHED;
            PG8_LDA(At, 0, 1); PG8_STAGE(PG8_SB(0, 0), b2, voffB); PG8_STAGE(PG8_SB(0, 1), b2 + hstep, voffB); PG8_STAGE(PG8_SA(0, 0), a2, voffA);
            PG8_WAIT_V(8); PG8_WAIT_L(0); PG8_BAR; PG8_MMA(1, 0, At, B0); PG8_MMA(1, 1, At, B1); PG8_BAR; PG8_SCHED;
            PG8_LDB(B0, 1, 0); PG8_LDB(B1, 1, 1); PG8_SCHED; PG8_LDA(At, 1, 0); PG8_STAGE(PG8_SA(0, 1), a2 + hstep, voffA);
            PG8_WAIT_V(8); PG8_WAIT_L(0); PG8_BAR; PG8_MMA(0, 0, At, B0); PG8_MMA(0, 1, At, B1); PG8_BAR; PG8_SCHED;
            PG8_LDA(At, 1, 1); PG8_STAGE(PG8_SB(1, 0), b3, voffB); PG8_STAGE(PG8_SB(1, 1), b3 + hstep, voffB); PG8_STAGE(PG8_SA(1, 0), a3, voffA);
            PG8_WAIT_V(8); PG8_WAIT_L(0); PG8_BAR; PG8_MMA(1, 0, At, B0); PG8_MMA(1, 1, At, B1); PG8_BAR; PG8_SCHED;
            } else {
            PG8_LDB(B0, 0, 0); PG8_SCHED; PG8_LDA(At, 0, 0); PG8_STAGE(PG8_SA(1, 1), a1 + hstep, voffA);
            PG8_WAIT_L(8); PG8_BAR; PG8_WAIT_L(0); PG8_MMA(0, 0, At, B0); PG8_BAR; PG8_SCHED;
            PG8_LDB(B1, 0, 1); PG8_STAGE(PG8_SB(0, 0), b2, voffB);
            PG8_BAR; PG8_WAIT_L(0); PG8_MMA(0, 1, At, B1); PG8_BAR;
            PG8_LDA(At, 0, 1); PG8_STAGE(PG8_SA(0, 0), a2, voffA);
            PG8_BAR; PG8_WAIT_L(0); PG8_MMA(1, 0, At, B0); PG8_BAR; PG8_SCHED;
            PG8_STAGE(PG8_SB(0, 1), b2 + hstep, voffB);
            PG8_WAIT_V(6); PG8_BAR; PG8_MMA(1, 1, At, B1); PG8_BAR;
            PG8_LDB(B0, 1, 0); PG8_SCHED; PG8_LDA(At, 1, 0); PG8_STAGE(PG8_SA(0, 1), a2 + hstep, voffA);
            PG8_WAIT_L(8); PG8_BAR; PG8_WAIT_L(0); PG8_MMA(0, 0, At, B0); PG8_BAR; PG8_SCHED;
            PG8_LDB(B1, 1, 1); PG8_STAGE(PG8_SB(1, 0), b3, voffB);
            PG8_BAR; PG8_WAIT_L(0); PG8_MMA(0, 1, At, B1); PG8_BAR;
            PG8_LDA(At, 1, 1); PG8_STAGE(PG8_SA(1, 0), a3, voffA);
            PG8_BAR; PG8_WAIT_L(0); PG8_MMA(1, 0, At, B0); PG8_BAR; PG8_SCHED;
            PG8_STAGE(PG8_SB(1, 1), b3 + hstep, voffB);
            PG8_WAIT_V(6); PG8_BAR; PG8_MMA(1, 1, At, B1); PG8_BAR;
            }
        }
        if constexpr (ALIGN_EPI) { if (wr == 0) PG8_BAR; }
        if constexpr (!Epi::AFTER_DRAIN) { E(acc, cur, wr, wc, fr, fq); S.done(cur); }
        if (!has_next) break;
#pragma unroll
        for (int a = 0; a < 2; ++a)
#pragma unroll
            for (int b = 0; b < 2; ++b)
#pragma unroll
                for (int m = 0; m < 4; ++m)
#pragma unroll
                    for (int n = 0; n < 2; ++n) acc[a][b][m][n] = (f32x4){0.f, 0.f, 0.f, 0.f};
        cur = nxt; cA = nA; cB = nB; ++ui;
        if constexpr (ALIGN_EPI) { if (wr == 1) PG8_BAR; }
    }
    PG8_WAIT_V(0);
    if constexpr (!ALIGN_EPI) { if (wr == 0) PG8_BAR; }
    PG8_BAR;
    if constexpr (Epi::AFTER_DRAIN) { E.fused(acc, cur, wr, wc, fr, fq, lds, wid, lane); S.done(cur); }
#undef PG8_SA
#undef PG8_SB
#undef PG8_STAGE
#undef PG8_LDA
#undef PG8_LDB
#undef PG8_MMA
#undef PG8_WAIT_V
#undef PG8_WAIT_L
#undef PG8_BAR
#undef PG8_SCHED
}
}
constexpr int S_ = 8192, DM = 2048, DFF = 8192, DPLE = 256, PROJ = 5656, PROJ_PAD = 5888, ZP = PROJ;
constexpr int MQ_OFF = 0, MK_OFF = 1024, MV_OFF = 2048, NQ_OFF = 3072, CK_OFF = 4096, CV_OFF = 4352, SK_OFF = 4608, SV_OFF = 4864, WK_OFF = 5120, WV_OFF = 5376, GL_OFF = 5632;
constexpr float LN_EPS = 1e-5f;
constexpr float DN_ALPHA = 1.189207115002721f;
constexpr int NWAVES = 8;
constexpr size_t MiB = 1u << 20;
constexpr size_t WS_CTL = 0;
constexpr size_t WS_LUT = 1 * MiB;
constexpr size_t WS_KMH = WS_LUT + 8192;
constexpr size_t WS_KML = WS_KMH + 65536;
constexpr size_t WS_KC  = WS_KML + 65536;
constexpr size_t WS_VCT = WS_KC + 262144;
constexpr size_t WS_SEL = WS_VCT + 262144;
constexpr size_t WS_W2T = WS_SEL + 262144;
constexpr size_t WS_CC  = WS_W2T + 65536;
constexpr size_t WS_WOUT = 2 * MiB, WS_WFF1 = 10 * MiB, WS_WFF2 = 42 * MiB, WS_WGATE = 74 * MiB, WS_WPLE = 82 * MiB;
constexpr size_t WS_PB = 83 * MiB;
constexpr size_t WS_A = 87 * MiB;
constexpr size_t WS_B = 119 * MiB;
constexpr size_t WS_W1T = WS_B + 23 * MiB;
constexpr size_t WS_C = 151 * MiB;
constexpr size_t WS_ON2 = WS_C + 89 * MiB;
constexpr size_t WS_END = 279 * MiB;
static_assert(WS_CC + 1024 <= WS_WOUT && (size_t)S_ * ZP * 2 <= 128 * MiB, "ws map");
constexpr int RING_BYTES = 131072, LDS_BYTES = 147456, MISC_OFF = 131072 + 8192;
#define GAS __attribute__((address_space(1)))
#define LAS __attribute__((address_space(3)))
typedef unsigned short bf16;
typedef unsigned v4u __attribute__((ext_vector_type(4)));
typedef float f32x4 __attribute__((ext_vector_type(4)));
__device__ __forceinline__ unsigned f2bf(float f) { unsigned u = __builtin_bit_cast(unsigned, f); return (u + 0x7fffu + ((u >> 16) & 1u)) >> 16; }
__device__ __forceinline__ unsigned pk2(float lo, float hi) { return f2bf(lo) | (f2bf(hi) << 16); }
#define LDS_WAIT() asm volatile("s_waitcnt lgkmcnt(0)" ::: "memory")
__device__ __forceinline__ float wave_sum(float v) {
#pragma unroll
    for (int o = 1; o < 64; o <<= 1) v += __shfl_xor(v, o);
    return v;
}
__device__ __forceinline__ void p0_tr_load(const float* W, int K, int N, int item, int tid, f32x4 (&v)[8]) {
    const int nblk = (N + 255) / 256, kb = item / nblk, nb = item % nblk, k0 = 64 * kb, n0 = 256 * nb;
    const int n = n0 + (tid & 63) * 4, kr = tid >> 6; const bool ok = n < N;
#pragma unroll
    for (int i = 0; i < 8; ++i) v[i] = ok ? *(const GAS f32x4*)(W + (size_t)(k0 + kr + 8 * i) * N + n) : (f32x4){0.f, 0.f, 0.f, 0.f};
}
__device__ __forceinline__ void p0_tr_store(int K, int N, bf16* WT, LAS float* scr, int item, int tid, const f32x4 (&v)[8]) {
    const int nblk = (N + 255) / 256, kb = item / nblk, nb = item % nblk, k0 = 64 * kb, n0 = 256 * nb;
    const int nl = (tid & 63) * 4, kr = tid >> 6;
#pragma unroll
    for (int i = 0; i < 8; ++i) { LAS float* d = scr + (kr + 8 * i) * 257 + nl; d[0] = v[i][0]; d[1] = v[i][1]; d[2] = v[i][2]; d[3] = v[i][3]; }
    __syncthreads();
    const int c = tid & 7;
#pragma unroll
    for (int j = 0; j < 4; ++j) { const int n = (tid >> 3) + 64 * j; const LAS float* s = scr + (8 * c) * 257 + n;
        v4u o; o.x = pk2(s[0 * 257], s[1 * 257]); o.y = pk2(s[2 * 257], s[3 * 257]); o.z = pk2(s[4 * 257], s[5 * 257]); o.w = pk2(s[6 * 257], s[7 * 257]);
        if (n0 + n < N) *(GAS v4u*)(WT + (size_t)(n0 + n) * K + k0 + 8 * c) = o; }
    __syncthreads();
}
__device__ __forceinline__ int t5_bucket(int n) {
    if (n < 16) return n;
    int b = 16;
    b += (n >= 19); b += (n >= 21); b += (n >= 24); b += (n >= 27); b += (n >= 31); b += (n >= 35); b += (n >= 40); b += (n >= 46);
    b += (n >= 52); b += (n >= 59); b += (n >= 67); b += (n >= 77); b += (n >= 87); b += (n >= 99); b += (n >= 113);
    return b;
}
struct Args { const float* in[19]; float* out; unsigned char* ws; int ph_lo, ph_hi; };
struct Frame {
    LAS unsigned char* lds; int tid, lane, wave, G, gw, NGW;
};
__device__ __forceinline__ void cvt_rows(const float* src, bf16* dst, size_t n8, int gt, int NGT) {
    size_t i = gt;
    for (; i + 3 * (size_t)NGT < n8; i += 4 * (size_t)NGT) { f32x4 a[4], b[4];
#pragma unroll
        for (int u = 0; u < 4; ++u) { a[u] = *(const GAS f32x4*)(src + (i + u * (size_t)NGT) * 8); b[u] = *(const GAS f32x4*)(src + (i + u * (size_t)NGT) * 8 + 4); }
#pragma unroll
        for (int u = 0; u < 4; ++u) { v4u o; o.x = pk2(a[u][0], a[u][1]); o.y = pk2(a[u][2], a[u][3]); o.z = pk2(b[u][0], b[u][1]); o.w = pk2(b[u][2], b[u][3]); *(GAS v4u*)(dst + (i + u * (size_t)NGT) * 8) = o; } }
    for (; i < n8; i += NGT) { const f32x4 a = *(const GAS f32x4*)(src + i * 8), b = *(const GAS f32x4*)(src + i * 8 + 4);
        v4u o; o.x = pk2(a[0], a[1]); o.y = pk2(a[2], a[3]); o.z = pk2(b[0], b[1]); o.w = pk2(b[2], b[3]); *(GAS v4u*)(dst + i * 8) = o; }
}
__device__ __forceinline__ void p0_prologue(const Frame& F, const Args& a) {
    unsigned char* ws = a.ws;
    LAS float* scr = (LAS float*)F.lds;
#define NIT(K_, N_) (((K_) / 64) * (((N_) + 255) / 256))
    constexpr int I0 = NIT(DM, PROJ), I1 = I0 + NIT(DM, DM), I2 = I1 + NIT(DM, DFF), I3 = I2 + NIT(DFF, DM), I4 = I3 + NIT(DM, DM), I5 = I4 + NIT(DPLE, DM), I6 = I5 + NIT(4096, 128), I7 = I6 + NIT(4096, 128), I8 = I7 + NIT(128, 128), I9 = I8 + NIT(128, 128);
#undef NIT
#define TSEL(it_, W_, K_, N_, WT_, loc_) do { \
        if ((it_) < I0) { W_ = a.in[2]; K_ = DM; N_ = PROJ; WT_ = (bf16*)(ws + WS_B); loc_ = (it_); } \
        else if ((it_) < I1) { W_ = a.in[10]; K_ = DM; N_ = DM; WT_ = (bf16*)(ws + WS_WOUT); loc_ = (it_) - I0; } \
        else if ((it_) < I2) { W_ = a.in[13]; K_ = DM; N_ = DFF; WT_ = (bf16*)(ws + WS_WFF1); loc_ = (it_) - I1; } \
        else if ((it_) < I3) { W_ = a.in[14]; K_ = DFF; N_ = DM; WT_ = (bf16*)(ws + WS_WFF2); loc_ = (it_) - I2; } \
        else if ((it_) < I4) { W_ = a.in[16]; K_ = DM; N_ = DM; WT_ = (bf16*)(ws + WS_WGATE); loc_ = (it_) - I3; } \
        else if ((it_) < I5) { W_ = a.in[15]; K_ = DPLE; N_ = DM; WT_ = (bf16*)(ws + WS_WPLE); loc_ = (it_) - I4; } \
        else if ((it_) < I6) { W_ = a.in[4]; K_ = 4096; N_ = 128; WT_ = (bf16*)(ws + WS_W1T); loc_ = (it_) - I5; } \
        else if ((it_) < I7) { W_ = a.in[7]; K_ = 4096; N_ = 128; WT_ = (bf16*)(ws + WS_W1T) + 128 * 4096; loc_ = (it_) - I6; } \
        else if ((it_) < I8) { W_ = a.in[5]; K_ = 128; N_ = 128; WT_ = (bf16*)(ws + WS_W2T); loc_ = (it_) - I7; } \
        else { W_ = a.in[8]; K_ = 128; N_ = 128; WT_ = (bf16*)(ws + WS_W2T) + 128 * 128; loc_ = (it_) - I8; } } while (0)
    {
        f32x4 v[8]; const float* W; int K, N, loc; bf16* WT;
        int it = blockIdx.x;
        if (it < I9) { TSEL(it, W, K, N, WT, loc); p0_tr_load(W, K, N, loc, F.tid, v); }
        while (it < I9) {
            const int K0 = K, N0 = N, loc0 = loc; bf16* const WT0 = WT;
            f32x4 cur[8];
#pragma unroll
            for (int i = 0; i < 8; ++i) cur[i] = v[i];
            const int itn = it + F.G;
            if (itn < I9) { TSEL(itn, W, K, N, WT, loc); p0_tr_load(W, K, N, loc, F.tid, v); }
            p0_tr_store(K0, N0, WT0, scr, loc0, F.tid, cur);
            it = itn;
        }
    }
#undef TSEL
    const int gt = F.gw * 64 + F.lane, NGT = F.NGW * 64;
    cvt_rows(a.in[0], (bf16*)(ws + WS_A), (size_t)S_ * DM / 8, gt, NGT);
    cvt_rows(a.in[1], (bf16*)(ws + WS_PB), (size_t)S_ * DPLE / 8, gt, NGT);
    if (blockIdx.x == 0) {
        float* lut = (float*)(ws + WS_LUT); const float* rb = a.in[9];
        for (int i = F.tid; i < 16 * 128; i += 512) { const int h = i >> 7, d = i & 127; lut[i] = (rb[t5_bucket(d) * 16 + h] - rb[31 * 16 + h]) * 11.313708498984761f; }
    }
}
template <bool FIRST> __device__ __forceinline__ void ln_rows(const Frame& F, float* io, bf16* hb, const float* g, const float* b) {
    for (int m = F.gw; m < S_; m += F.NGW) {
        GAS f32x4* xr = (GAS f32x4*)(io + (size_t)m * DM) + F.lane;
        f32x4 v[8]; float s = 0.f;
#pragma unroll
        for (int j = 0; j < 8; ++j) { v[j] = xr[64 * j]; s += (v[j][0] + v[j][1]) + (v[j][2] + v[j][3]); }
        const float mean = wave_sum(s) * (1.f / DM); float s2 = 0.f;
#pragma unroll
        for (int j = 0; j < 8; ++j) { v[j] = v[j] - mean; s2 += (v[j][0] * v[j][0] + v[j][1] * v[j][1]) + (v[j][2] * v[j][2] + v[j][3] * v[j][3]); }
        const float rstd = 1.f / sqrtf(wave_sum(s2) * (1.f / DM) + LN_EPS);
#pragma unroll
        for (int j = 0; j < 8; ++j) { const f32x4 gg = *((const GAS f32x4*)g + F.lane + 64 * j), bb = *((const GAS f32x4*)b + F.lane + 64 * j);
            const f32x4 o = v[j] * rstd * gg + bb;
            if (FIRST) { xr[64 * j] = o * DN_ALPHA; typedef unsigned u32x2 __attribute__((ext_vector_type(2))); u32x2 w; w.x = pk2(o[0], o[1]); w.y = pk2(o[2], o[3]);
                *((GAS u32x2*)(hb + (size_t)m * DM) + F.lane + 64 * j) = w; }
            else xr[64 * j] = o; }
    }
}
namespace mx {
typedef short bf16x8 __attribute__((ext_vector_type(8)));
typedef float f32x16 __attribute__((ext_vector_type(16)));
typedef unsigned u32x4 __attribute__((ext_vector_type(4)));
typedef float f32x2_t __attribute__((ext_vector_type(2))); typedef __bf16 bf16x2_t __attribute__((ext_vector_type(2)));
__device__ __forceinline__ unsigned cvtpk(float lo, float hi) { f32x2_t v = {lo, hi}; bf16x2_t b = __builtin_convertvector(v, bf16x2_t); return __builtin_bit_cast(unsigned, b); }
__device__ __forceinline__ bf16x8 pack8(f32x4 a, f32x4 b) { u32x4 w = {cvtpk(a[0], a[1]), cvtpk(a[2], a[3]), cvtpk(b[0], b[1]), cvtpk(b[2], b[3])}; return __builtin_bit_cast(bf16x8, w); }
__device__ __forceinline__ float bf2f(unsigned short h) { return __uint_as_float((unsigned)h << 16); }
__device__ __forceinline__ int crow(int r, int hi) { return (r & 3) + 8 * (r >> 2) + 4 * hi; }

__device__ __forceinline__ void kmean_item(const Frame& F, const bf16* z, int h, int j, bf16* kmh, bf16* kml) {
    LAS float* red = (LAS float*)F.lds;
    const int cgp = F.tid & 15, rg = F.tid >> 4; float a[8] = {0.f, 0.f, 0.f, 0.f, 0.f, 0.f, 0.f, 0.f};
#pragma unroll
    for (int i = 0; i < 8; ++i) { const v4u w = *(const GAS v4u*)(z + (size_t)(256 * j + rg * 8 + i) * ZP + MK_OFF + h * 128 + cgp * 8);
        a[0] += __uint_as_float(w.x << 16); a[1] += __uint_as_float(w.x & 0xffff0000u); a[2] += __uint_as_float(w.y << 16); a[3] += __uint_as_float(w.y & 0xffff0000u);
        a[4] += __uint_as_float(w.z << 16); a[5] += __uint_as_float(w.z & 0xffff0000u); a[6] += __uint_as_float(w.w << 16); a[7] += __uint_as_float(w.w & 0xffff0000u); }
#pragma unroll
    for (int i = 0; i < 8; ++i) red[rg * 128 + cgp * 8 + i] = a[i];
    __syncthreads();
    if (F.tid < 128) { float s = 0.f;
#pragma unroll 8
        for (int r = 0; r < 32; ++r) s += red[r * 128 + F.tid];
        s *= (1.f / 256.f); const unsigned hb = f2bf(s); const float hf = __uint_as_float(hb << 16);
        kmh[(h * 32 + j) * 128 + F.tid] = (bf16)hb; kml[(h * 32 + j) * 128 + F.tid] = (bf16)f2bf(s - hf); }
    __syncthreads();
}
__device__ __forceinline__ void compress_item(const Frame& F, const bf16* z, int col_off, const bf16* w1T, const bf16* w2T, const float* pe, int rgp, int kv, bf16* kc, bf16* vcT) {
    const int lane = F.lane, r32 = lane & 31, hi = lane >> 5, w = F.wave;
    const int rho = 32 * rgp + r32, n = rho >> 1, g = rho & 1; const int nn = n > 510 ? 510 : n;
    f32x16 acc[4];
#pragma unroll
    for (int eb = 0; eb < 4; ++eb) acc[eb] = f32x16{};
#pragma unroll 1
    for (int ll = 0; ll < 4; ++ll) { const int l = 4 * w + ll; const bf16* arow = z + (size_t)(16 * nn + l) * ZP + col_off + g * 128 + hi * 8;
#pragma unroll
        for (int dd = 0; dd < 8; ++dd) { const u32x4 ar = *(const GAS u32x4*)(arow + dd * 16); const int k0 = l * 128 + dd * 16 + hi * 8;
            const f32x4 pe0 = *(const GAS f32x4*)(pe + k0), pe1 = *(const GAS f32x4*)(pe + k0 + 4);
            const f32x4 x0 = {__uint_as_float(ar.x << 16) + pe0[0], __uint_as_float(ar.x & 0xffff0000u) + pe0[1], __uint_as_float(ar.y << 16) + pe0[2], __uint_as_float(ar.y & 0xffff0000u) + pe0[3]};
            const f32x4 x1 = {__uint_as_float(ar.z << 16) + pe1[0], __uint_as_float(ar.z & 0xffff0000u) + pe1[1], __uint_as_float(ar.w << 16) + pe1[2], __uint_as_float(ar.w & 0xffff0000u) + pe1[3]};
            const bf16x8 a = pack8(x0, x1);
#pragma unroll
            for (int eb = 0; eb < 4; ++eb) { const bf16x8 b = *(const GAS bf16x8*)(w1T + (size_t)(eb * 32 + r32) * 4096 + k0);
                acc[eb] = __builtin_amdgcn_mfma_f32_32x32x16_bf16(a, b, acc[eb], 0, 0, 0); } } }
    LAS float* part = (LAS float*)F.lds;
#pragma unroll
    for (int eb = 0; eb < 4; ++eb)
#pragma unroll
        for (int r = 0; r < 16; ++r) part[(w * 32 + crow(r, hi)) * 128 + eb * 32 + r32] = acc[eb][r];
    __syncthreads();
    for (int i = F.tid; i < 32 * 128; i += 512) { float s = 0.f;
#pragma unroll
        for (int p = 0; p < 8; ++p) s += part[p * 4096 + i];
        const float y = 0.7978845608028654f * (s + 0.044715f * s * s * s); const float t = 1.f - 2.f / (1.f + __expf(2.f * y));
        part[i] = 0.5f * s * (1.f + t); }
    __syncthreads();
    if (w < 4) {
        f32x16 o = f32x16{};
#pragma unroll
        for (int kk = 0; kk < 8; ++kk) { const LAS float* hp = part + r32 * 128 + kk * 16 + hi * 8; const f32x4 x0 = *(const LAS f32x4*)hp, x1 = *(const LAS f32x4*)(hp + 4);
            const bf16x8 a = pack8(x0, x1); const bf16x8 b = *(const GAS bf16x8*)(w2T + (size_t)(w * 32 + r32) * 128 + kk * 16 + hi * 8);
            o = __builtin_amdgcn_mfma_f32_32x32x16_bf16(a, b, o, 0, 0, 0); }
#pragma unroll
        for (int r = 0; r < 16; ++r) { const int row = crow(r, hi), rr = 32 * rgp + row, n2 = rr >> 1, g2 = rr & 1, f = w * 32 + r32;
            const float v = n2 <= 510 ? o[r] : 0.f;
            if (kv == 0) kc[(size_t)(g2 * 512 + n2) * 128 + f] = (bf16)f2bf(v); else vcT[(size_t)(g2 * 128 + f) * 512 + n2] = (bf16)f2bf(v); }
    }
    __syncthreads();
}
__device__ __forceinline__ void mixer_pre_a(const Frame& F, const Args& a) {
    unsigned char* ws = a.ws; const bf16* z = (const bf16*)(ws + WS_C);
    for (int it = blockIdx.x; it < 64 + 256; it += F.G) {
        if (it < 64) { const int kv = it & 1, rgp = it >> 1;
            compress_item(F, z, kv ? CV_OFF : CK_OFF, (const bf16*)(ws + WS_W1T) + (size_t)kv * 128 * 4096, (const bf16*)(ws + WS_W2T) + kv * 128 * 128, kv ? a.in[6] : a.in[3], rgp, kv, (bf16*)(ws + WS_KC), (bf16*)(ws + WS_VCT)); }
        else { const int k = it - 64; kmean_item(F, z, k & 7, k >> 3, (bf16*)(ws + WS_KMH), (bf16*)(ws + WS_KML)); }
    }
}
}
namespace mx {
constexpr float SM_SCALE = 0.08838834764831845f;
constexpr float C2 = 1.4426950408889634f * SM_SCALE;
constexpr int LUT_OFF = 131072;
#define PK4(P, B_, OUT) do { unsigned a0 = cvtpk(P[B_+0], P[B_+1]), a1 = cvtpk(P[B_+2], P[B_+3]);                          \
        unsigned b0 = cvtpk(P[B_+4], P[B_+5]), b1 = cvtpk(P[B_+6], P[B_+7]);                                             \
        auto r0 = __builtin_amdgcn_permlane32_swap(a0, b0, false, false); auto r1 = __builtin_amdgcn_permlane32_swap(a1, b1, false, false); \
        u32x4 w = {r0[0], r1[0], r0[1], r1[1]}; OUT = __builtin_bit_cast(bf16x8, w); } while (0)
__device__ __forceinline__ void load_lut(const Frame& F, const float* lut_g) {
    LAS float* lut = (LAS float*)(F.lds + LUT_OFF);
    for (int i = F.tid; i < 16 * 128; i += 512) lut[i] = lut_g[i];
    __syncthreads();
}
__device__ __forceinline__ void cmp_scores(f32x16& p0, f32x16& p1, const bf16* kcg, int tt, const bf16x8* qr, int r32, int hi, int t, const LAS float* lutp) {
    p0 = f32x16{}; p1 = f32x16{};
    const bf16* k0 = kcg + (size_t)(64 * tt + r32) * 128 + hi * 8;
#pragma unroll
    for (int d0 = 0; d0 < 8; ++d0) { const bf16x8 b0 = *(const GAS bf16x8*)(k0 + d0 * 16), b1 = *(const GAS bf16x8*)(k0 + 32 * 128 + d0 * 16);
        p0 = __builtin_amdgcn_mfma_f32_32x32x16_bf16(b0, qr[d0], p0, 0, 0, 0); p1 = __builtin_amdgcn_mfma_f32_32x32x16_bf16(b1, qr[d0], p1, 0, 0, 0); }
    const float NEG = -__builtin_inff();
    const int dq = t - 31 - 16 * (64 * tt + 4 * hi);
#pragma unroll
    for (int r = 0; r < 16; ++r) { const int c = (r & 3) + 8 * (r >> 2); const int d0 = dq - 16 * c, d1 = d0 - 16 * 32;
        const float b0 = lutp[min((unsigned)d0, 127u)], b1 = lutp[min((unsigned)d1, 127u)];
        p0[r] = d0 >= 0 ? p0[r] + b0 : NEG; p1[r] = d1 >= 0 ? p1[r] + b1 : NEG; }
}
__device__ __forceinline__ float hmax32(const f32x16& p0, const f32x16& p1) {
    float m = p0[0];
#pragma unroll
    for (int r = 1; r < 16; ++r) m = fmaxf(m, p0[r]);
#pragma unroll
    for (int r = 0; r < 16; ++r) m = fmaxf(m, p1[r]);
    auto rr = __builtin_amdgcn_permlane32_swap(__float_as_uint(m), __float_as_uint(m), false, false);
    return fmaxf(__uint_as_float(rr[0]), __uint_as_float(rr[1]));
}
__device__ __forceinline__ float hsum32(const f32x16& p0, const f32x16& p1) {
    float s = 0.f;
#pragma unroll
    for (int r = 0; r < 16; ++r) s += p0[r];
#pragma unroll
    for (int r = 0; r < 16; ++r) s += p1[r];
    auto rr = __builtin_amdgcn_permlane32_swap(__float_as_uint(s), __float_as_uint(s), false, false);
    return __uint_as_float(rr[0]) + __uint_as_float(rr[1]);
}
__device__ __forceinline__ void cmp_item(const Frame& F, const Args& a, int g, int tg) {
    unsigned char* ws = a.ws; const bf16* z = (const bf16*)(ws + WS_C);
    const bf16* kcg = (const bf16*)(ws + WS_KC) + (size_t)g * 512 * 128; const bf16* vcg = (const bf16*)(ws + WS_VCT) + (size_t)g * 128 * 512;
    float* On = (float*)(ws + WS_B); unsigned* sel = (unsigned*)(ws + WS_SEL);
    const int lane = F.lane, r32 = lane & 31, hi = lane >> 5, w = F.wave;
    const int t0 = 8 * tg, tl = r32 >> 2, hl = r32 & 3, t = t0 + tl;
    const LAS float* lutp = (const LAS float*)(F.lds + LUT_OFF) + (8 + 4 * g + hl) * 128;
    LAS float* impG = (LAS float*)(F.lds + w * 12288);
    LAS float* impL = impG + 1024;
    LAS float* wsc = impL + 8 * 136;
    for (int i = lane; i < 1024 + 8 * 136; i += 64) impG[i] = 0.f;
    bf16x8 qr[8];
    { const bf16* qp = z + (size_t)t * ZP + NQ_OFF + (4 * g + hl) * 128 + hi * 8;
#pragma unroll
      for (int d0 = 0; d0 < 8; ++d0) qr[d0] = *(const GAS bf16x8*)(qp + d0 * 16); }
    const int tmax = t0 + 7; const int nmaxw = tmax >= 31 ? (tmax - 31) >> 4 : -1; const int NT = nmaxw >= 0 ? (nmaxw >> 6) + 1 : 0;
    float m = -1e30f, l = 0.f;
    for (int tt = 0; tt < NT; ++tt) { f32x16 p0, p1; cmp_scores(p0, p1, kcg, tt, qr, r32, hi, t, lutp);
        const float pm = hmax32(p0, p1) * C2; const float mn = fmaxf(m, pm); const float al = __builtin_amdgcn_exp2f(m - mn); m = mn;
#pragma unroll
        for (int r = 0; r < 16; ++r) { p0[r] = __builtin_amdgcn_exp2f(fmaf(p0[r], C2, -mn)); p1[r] = __builtin_amdgcn_exp2f(fmaf(p1[r], C2, -mn)); }
        l = l * al + hsum32(p0, p1); }
    const float rl = l > 0.f ? 1.f / l : 0.f;
    f32x16 o[4] = {f32x16{}, f32x16{}, f32x16{}, f32x16{}};
    for (int tt = 0; tt < NT; ++tt) { f32x16 p0, p1; cmp_scores(p0, p1, kcg, tt, qr, r32, hi, t, lutp);
#pragma unroll
        for (int r = 0; r < 16; ++r) { p0[r] = __builtin_amdgcn_exp2f(fmaf(p0[r], C2, -m)) * rl; p1[r] = __builtin_amdgcn_exp2f(fmaf(p1[r], C2, -m)) * rl; }
#pragma unroll
        for (int a4 = 0; a4 < 4; ++a4) {
            float g0 = (p0[4 * a4] + p0[4 * a4 + 1]) + (p0[4 * a4 + 2] + p0[4 * a4 + 3]), g1 = (p1[4 * a4] + p1[4 * a4 + 1]) + (p1[4 * a4 + 2] + p1[4 * a4 + 3]);
            float e0 = p0[4 * a4 + 3], e1 = p1[4 * a4 + 3];
            g0 += __shfl_xor(g0, 1); g0 += __shfl_xor(g0, 2); g1 += __shfl_xor(g1, 1); g1 += __shfl_xor(g1, 2);
            e0 += __shfl_xor(e0, 1); e0 += __shfl_xor(e0, 2); e1 += __shfl_xor(e1, 1); e1 += __shfl_xor(e1, 2);
            if (hl == 0) { const int j0 = 16 * tt + 2 * a4 + hi; impG[tl * 128 + j0] = g0; impG[tl * 128 + j0 + 8] = g1; impL[tl * 136 + j0 + 1] = e0; impL[tl * 136 + j0 + 9] = e1; } }
        bf16x8 pa0, pa1, pa2, pa3; PK4(p0, 0, pa0); PK4(p0, 8, pa1); PK4(p1, 0, pa2); PK4(p1, 8, pa3);
#pragma unroll
        for (int d0 = 0; d0 < 4; ++d0) { const bf16* vp = vcg + (size_t)(d0 * 32 + r32) * 512 + 64 * tt + hi * 8;
            const bf16x8 v0 = *(const GAS bf16x8*)(vp), v1 = *(const GAS bf16x8*)(vp + 16), v2 = *(const GAS bf16x8*)(vp + 32), v3 = *(const GAS bf16x8*)(vp + 48);
            o[d0] = __builtin_amdgcn_mfma_f32_32x32x16_bf16(pa0, v0, o[d0], 0, 0, 0); o[d0] = __builtin_amdgcn_mfma_f32_32x32x16_bf16(pa1, v1, o[d0], 0, 0, 0);
            o[d0] = __builtin_amdgcn_mfma_f32_32x32x16_bf16(pa2, v2, o[d0], 0, 0, 0); o[d0] = __builtin_amdgcn_mfma_f32_32x32x16_bf16(pa3, v3, o[d0], 0, 0, 0); } }
    if (hi == 0) { const float gl = bf2f(z[(size_t)t * ZP + GL_OFF + g * 12 + hl * 3 + 0]); wsc[r32] = 1.f / (1.f + __expf(-gl)); }
    LDS_WAIT(); asm volatile("" ::: "memory");
#pragma unroll
    for (int r = 0; r < 16; ++r) { const int q = crow(r, hi); const float gt = wsc[q]; float* op = On + (size_t)(t0 + (q >> 2)) * 1024 + (4 * g + (q & 3)) * 128 + r32;
#pragma unroll
        for (int d0 = 0; d0 < 4; ++d0) op[d0 * 32] = o[d0][r] * gt; }
    LDS_WAIT(); asm volatile("" ::: "memory");
    const unsigned long long lt_mask = (1ull << lane) - 1ull;
#pragma unroll 1
    for (int k = 0; k < 8; ++k) { const int tk = t0 + k, cur = tk >> 6; unsigned long long s0, s1;
        if (cur <= 15) { s0 = (cur >= 63) ? ~0ull : ((2ull << cur) - 1ull); s1 = 0ull; }
        else {
            const int j0 = lane, j1 = lane + 64;
            const float v0 = impG[k * 128 + j0] + impL[k * 136 + j0], v1 = impG[k * 128 + j1] + impL[k * 136 + j1];
            const unsigned u0 = (j0 >= 1 && j0 <= cur - 2) ? __float_as_uint(v0) + 1u : 0u, u1 = (j1 <= cur - 2) ? __float_as_uint(v1) + 1u : 0u;
            unsigned T = 0u;
#pragma unroll 1
            for (int b = 30; b >= 0; --b) { const unsigned cand = T | (1u << b);
                const int cnt = __builtin_popcountll(__builtin_amdgcn_ballot_w64(u0 >= cand)) + __builtin_popcountll(__builtin_amdgcn_ballot_w64(u1 >= cand));
                if (cnt >= 13) T = cand; }
            const unsigned long long gt0 = __builtin_amdgcn_ballot_w64(u0 > T), gt1 = __builtin_amdgcn_ballot_w64(u1 > T);
            const unsigned long long eq0 = __builtin_amdgcn_ballot_w64(u0 == T), eq1 = __builtin_amdgcn_ballot_w64(u1 == T);
            const int need = 13 - __builtin_popcountll(gt0) - __builtin_popcountll(gt1);
            const int rk0 = __builtin_popcountll(eq0 & lt_mask), rk1 = __builtin_popcountll(eq0) + __builtin_popcountll(eq1 & lt_mask);
            const bool f0 = (j0 == 0) || (j0 == cur) || (j0 == cur - 1), f1 = (j1 == cur) || (j1 == cur - 1);
            s0 = __builtin_amdgcn_ballot_w64(f0 || u0 > T || (u0 == T && rk0 < need)); s1 = __builtin_amdgcn_ballot_w64(f1 || u1 > T || (u1 == T && rk1 < need));
        }
        if (lane == 0) { u32x4 wv = {(unsigned)s0, (unsigned)(s0 >> 32), (unsigned)s1, (unsigned)(s1 >> 32)}; *(GAS u32x4*)(sel + ((size_t)tk * 2 + g) * 4) = wv; } }
    LDS_WAIT(); asm volatile("" ::: "memory");
}
__device__ __forceinline__ void mixer_pre_b(const Frame& F, const Args& a) {
    load_lut(F, (const float*)(a.ws + WS_LUT));
    for (int it = F.gw; it < 2048; it += F.NGW) { const int g = it & 1, k = it >> 1; cmp_item(F, a, g, k); }
}
}
namespace mx {
constexpr int NW = 8, QBLK = 32, KVBLK = 64, HD = 128;
constexpr int SHM_V = KVBLK * HD * 2, SHM_K = KVBLK * HD * 2;
constexpr float THR = 8.f;
typedef short s16x4 __attribute__((ext_vector_type(4)));
#define KSWZ(row, colB) ((row) * 256 + ((colB) ^ (((row) & 7) << 4)))
#define SBAR() __builtin_amdgcn_sched_barrier(0)
__device__ __forceinline__ int v_st(int k, int c) { const int kk = (k & ~0xC) | ((k & 4) << 1) | ((k & 8) >> 1); return ((kk >> 3) * 4 + (c >> 5)) * 512 + ((kk & 7) * 32 + (c & 31)) * 2; }
__device__ __forceinline__ int v_rd_base(int lane) { return ((lane & 3) << 3) | (((lane >> 2) & 3) << 6) | (((lane >> 4) & 1) << 5) | (((lane >> 5) & 1) << 8); }
constexpr int v_rd_off(int d0, int ks, int half) { return d0 * 512 + ks * 4096 + half * 2048; }
enum { MODE_MOBA = 0, MODE_SLC = 1, MODE_WIN = 2 };
__device__ __forceinline__ void mask_tile(f32x16& p0, f32x16& p1, int dq, unsigned W, bool rowsel, const LAS float* lutp) {
    const float NEG = -__builtin_inff();
#pragma unroll
    for (int r4 = 0; r4 < 16; r4 += 4) {
#pragma unroll
        for (int r = r4; r < r4 + 4; ++r) { const int c = (r & 3) + 8 * (r >> 2); const int d0 = dq - c, d1 = dq - c - 32;
            const float b0 = lutp[min((unsigned)d0, 127u)], b1 = lutp[min((unsigned)d1, 127u)];
            p0[r] = (rowsel && (unsigned)d0 < W) ? p0[r] + b0 : NEG; p1[r] = (rowsel && (unsigned)d1 < W) ? p1[r] + b1 : NEG; }
        asm volatile("" ::: "memory"); }
}
__device__ __forceinline__ void mask_rows(f32x16& p0, f32x16& p1, bool rowsel) {
    const float NEG = -__builtin_inff();
#pragma unroll
    for (int r = 0; r < 16; ++r) { p0[r] = rowsel ? p0[r] : NEG; p1[r] = rowsel ? p1[r] : NEG; }
}
__device__ __forceinline__ void partialSM(f32x16& p0, f32x16& p1, float& m_reg, float& mn, float& alpha) {
    float pmax = p0[0];
#pragma unroll
    for (int r = 1; r < 16; ++r) pmax = fmaxf(pmax, p0[r]);
#pragma unroll
    for (int r = 0; r < 16; ++r) pmax = fmaxf(pmax, p1[r]);
    { auto rr = __builtin_amdgcn_permlane32_swap(__float_as_uint(pmax), __float_as_uint(pmax), false, false);
      pmax = fmaxf(__uint_as_float(rr[0]), __uint_as_float(rr[1])); }
    if (__builtin_expect(__all((pmax - m_reg) * SM_SCALE <= THR), 1)) { mn = m_reg; alpha = 1.f; }
    else { mn = fmaxf(m_reg, pmax); alpha = __builtin_amdgcn_exp2f((m_reg - mn) * C2); m_reg = mn; }
    const float mnL = -mn * C2;
#pragma unroll
    for (int r = 0; r < 16; ++r) p0[r] = fmaf(p0[r], C2, mnL);
#pragma unroll
    for (int r = 0; r < 16; ++r) p1[r] = fmaf(p1[r], C2, mnL);
#pragma unroll
    for (int r = 0; r < 16; ++r) p0[r] = __builtin_amdgcn_exp2f(p0[r]);
}
__device__ __forceinline__ void finishSM(f32x16& p0, f32x16& p1, float alpha, float& l_reg, bf16x8& pa0, bf16x8& pa1, bf16x8& pa2, bf16x8& pa3) {
#pragma unroll
    for (int r = 0; r < 16; ++r) p1[r] = __builtin_amdgcn_exp2f(p1[r]);
    float ps = 0;
#pragma unroll
    for (int r = 0; r < 16; ++r) ps += p0[r];
#pragma unroll
    for (int r = 0; r < 16; ++r) ps += p1[r];
    { auto rr = __builtin_amdgcn_permlane32_swap(__float_as_uint(ps), __float_as_uint(ps), false, false);
      ps = __uint_as_float(rr[0]) + __uint_as_float(rr[1]); }
    l_reg = l_reg * alpha + ps;
    PK4(p0, 0, pa0); PK4(p0, 8, pa1); PK4(p1, 0, pa2); PK4(p1, 8, pa3);
}
template <int KB>
__device__ __forceinline__ void qkt(f32x16& p0, f32x16& p1, const char* K_lds, int r32, int hi, const bf16x8* qr) {
    p0 = f32x16{}; p1 = f32x16{};
    const char* kb[4];
#pragma unroll
    for (int dd = 0; dd < 4; ++dd) kb[dd] = K_lds + KB * SHM_K + KSWZ(r32, (dd * 16 + hi * 8) * 2);
#pragma unroll
    for (int d0 = 0; d0 < 8; ++d0) { const char* a = kb[d0 & 3] + (d0 >> 2) * 128;
        bf16x8 b0 = *reinterpret_cast<const bf16x8*>(a);
        bf16x8 b1 = *reinterpret_cast<const bf16x8*>(a + 32 * 256);
        p0 = __builtin_amdgcn_mfma_f32_32x32x16_bf16(b0, qr[d0], p0, 0, 0, 0);
        p1 = __builtin_amdgcn_mfma_f32_32x32x16_bf16(b1, qr[d0], p1, 0, 0, 0); }
}
template <int VB>
__device__ __forceinline__ void pv_tile(f32x16* o, int vb0, bf16x8 pa0, bf16x8 pa1, bf16x8 pa2, bf16x8 pa3) {
#define TRRD(dst, off) asm volatile("ds_read_b64_tr_b16 %0, %1 offset:%2" : "=&v"(dst) : "v"(vb0), "i"(off) : "memory")
#define PV_D0(d0) do { s16x4 l0, l1, l2, l3, h0, h1, h2, h3; constexpr int b_ = VB * SHM_V + v_rd_off(d0, 0, 0); \
        TRRD(l0, b_); TRRD(h0, b_ + 2048); TRRD(l1, b_ + 4096); TRRD(h1, b_ + 6144); TRRD(l2, b_ + 8192); TRRD(h2, b_ + 10240); TRRD(l3, b_ + 12288); TRRD(h3, b_ + 14336); \
        asm volatile("s_waitcnt lgkmcnt(0)" ::: "memory"); SBAR(); \
        o[d0] = __builtin_amdgcn_mfma_f32_32x32x16_bf16(pa0, (bf16x8){l0[0], l0[1], l0[2], l0[3], h0[0], h0[1], h0[2], h0[3]}, o[d0], 0, 0, 0);   \
        o[d0] = __builtin_amdgcn_mfma_f32_32x32x16_bf16(pa1, (bf16x8){l1[0], l1[1], l1[2], l1[3], h1[0], h1[1], h1[2], h1[3]}, o[d0], 0, 0, 0);   \
        o[d0] = __builtin_amdgcn_mfma_f32_32x32x16_bf16(pa2, (bf16x8){l2[0], l2[1], l2[2], l2[3], h2[0], h2[1], h2[2], h2[3]}, o[d0], 0, 0, 0);   \
        o[d0] = __builtin_amdgcn_mfma_f32_32x32x16_bf16(pa3, (bf16x8){l3[0], l3[1], l3[2], l3[3], h3[0], h3[1], h3[2], h3[3]}, o[d0], 0, 0, 0); } while (0)
    PV_D0(0); PV_D0(1); PV_D0(2); PV_D0(3);
#undef PV_D0
#undef TRRD
}
struct Blk { int mode, hg, idx; };
__device__ __forceinline__ int blk_jlo(const Blk& b) { return b.mode == MODE_WIN ? (b.idx > 8 ? b.idx - 8 : 0) : 0; }
__device__ __forceinline__ int blk_jhi(const Blk& b) { return b.mode == MODE_MOBA ? 4 * (b.idx + 1) : b.idx + 1; }
__device__ __forceinline__ int blk_koff(const Blk& b) { return b.mode == MODE_MOBA ? MK_OFF + b.hg * 128 : (b.mode == MODE_SLC ? SK_OFF : WK_OFF) + b.hg * 128; }
__device__ __forceinline__ int blk_voff(const Blk& b) { return b.mode == MODE_MOBA ? MV_OFF + b.hg * 128 : (b.mode == MODE_SLC ? SV_OFF : WV_OFF) + b.hg * 128; }
__device__ __forceinline__ int blk_tok(const Blk& b, int wid, int r32) { return b.mode == MODE_MOBA ? 256 * b.idx + 32 * wid + r32 : 64 * b.idx + 8 * wid + (r32 >> 2); }
__device__ __forceinline__ int blk_qcol(const Blk& b, int r32) { return b.mode == MODE_MOBA ? MQ_OFF + b.hg * 128 : NQ_OFF + (4 * b.hg + (r32 & 3)) * 128; }
struct Seam { bf16x8 qr[8]; bf16x8 st_v0, st_v1, st_k0, st_k1; };
#define VMW() asm volatile("s_waitcnt vmcnt(0)" ::: "memory")
#define VMWN(n) asm volatile("s_waitcnt vmcnt(%0)" :: "i"(n) : "memory")
#define SLOAD_H(ko, vo, k0) do { const char* kb__ = (const char*)z + ((size_t)(k0) * ZP + (ko)) * 2; const char* vb__ = (const char*)z + ((size_t)(k0) * ZP + (vo)) * 2; \
                         S.st_v0 = *(const GAS bf16x8*)(vb__ + roff0); S.st_v1 = *(const GAS bf16x8*)(vb__ + roff1);              \
                         S.st_k0 = *(const GAS bf16x8*)(kb__ + roff0); S.st_k1 = *(const GAS bf16x8*)(kb__ + roff1); } while (0)
#define SWRITE_HK(bf) do { *(bf16x8*)(K_lds + (bf) * SHM_K + kws) = S.st_k0; *(bf16x8*)(K_lds + (bf) * SHM_K + kws + 32 * 256) = S.st_k1; } while (0)
#define SWRITE_HV(bf) do { *(bf16x8*)(V_lds + (bf) * SHM_V + vst0) = S.st_v0; *(bf16x8*)(V_lds + (bf) * SHM_V + vst1) = S.st_v1; } while (0)
#define SWRITE_H(bf) do { SWRITE_HV(bf); SWRITE_HK(bf); } while (0)
__device__ __forceinline__ void att_prime(const Blk& cur, const bf16* z, char* lds, Seam& S, const int tid) {
    const int  wid = __builtin_amdgcn_readfirstlane(tid >> 6), lane = tid & 63, r32 = lane & 31, hi = lane >> 5;
    const int sr = tid >> 4, sc = (tid & 15) * 8, kws = KSWZ(sr, sc * 2); char* K_lds = lds + 2 * SHM_V;
    const int kb0 = blk_jlo(cur) * KVBLK; const int ko = blk_koff(cur), vo = blk_voff(cur);
    const unsigned roff0 = (unsigned)(sr * ZP + sc) * 2u, roff1 = roff0 + 32u * ZP * 2u;
    { const unsigned qoff = (unsigned)(blk_tok(cur, wid, r32) * ZP + blk_qcol(cur, r32) + hi * 8) * 2u;
#pragma unroll
      for (int d0 = 0; d0 < 8; ++d0) S.qr[d0] = *(const GAS bf16x8*)((const char*)z + qoff + d0 * 32); }
    SLOAD_H(ko, vo, kb0); VMW(); SWRITE_HK(0);
    __syncthreads();
}
__device__ __forceinline__ void att_block(const Blk& cur, const Blk& nxt, const Args& a, char* lds, Seam& S, const int tid_in) {
    const int MODE = cur.mode; int tid = tid_in; asm volatile("" : "+v"(tid));
    unsigned char* ws = a.ws; const bf16* z = (const bf16*)(ws + WS_C);
    const int wid = __builtin_amdgcn_readfirstlane(tid >> 6), lane = tid & 63, r32 = lane & 31, hi = lane >> 5;
    const int j_lo = blk_jlo(cur), j_hi = blk_jhi(cur), NT = j_hi - j_lo;
    const int kbn = blk_jlo(nxt) * KVBLK; const int ko = blk_koff(cur), vo = blk_voff(cur), kon = blk_koff(nxt), von = blk_voff(nxt);
    const int qpos = blk_tok(cur, wid, r32);
    const int qlo = MODE == MODE_MOBA ? 256 * cur.idx + 32 * wid : 64 * cur.idx + 8 * wid, qhi = qlo + (MODE == MODE_MOBA ? 31 : 7);
    const int qm = qpos - 4 * hi;
    const unsigned W = MODE == MODE_WIN ? 512u : 0x7fffffffu; const int Wedge = MODE == MODE_WIN ? 512 : 0x40000000;
    const LAS float* lutp = (const LAS float*)((LAS unsigned char*)lds + LUT_OFF) + (MODE == MODE_MOBA ? cur.hg : 8 + 4 * cur.hg + (r32 & 3)) * 128;
    char* V_lds = lds; char* K_lds = lds + 2 * SHM_V;
    LAS float* wsf = (LAS float*)((LAS unsigned char*)lds + 2 * SHM_V + 2 * SHM_K) + wid * 64; LAS float* li_l = wsf; LAS float* al_l = wsf + 32;
    LAS float* li_h = li_l + 4 * hi; LAS float* al_h = al_l + 4 * hi; asm volatile("" : "+v"(li_h), "+v"(al_h));
    unsigned sw0 = 0u, sw1 = 0u, sw2 = 0u, sw3 = 0u;
    if (MODE == MODE_WIN) { sw0 = sw1 = sw2 = sw3 = 0xffffffffu; }
    if (MODE == MODE_SLC) { const u32x4 wv = *(const GAS u32x4*)((const unsigned*)(ws + WS_SEL) + ((size_t)qpos * 2 + cur.hg) * 4); sw0 = wv.x; sw1 = wv.y; sw2 = wv.z; sw3 = wv.w; }
    if (MODE == MODE_MOBA) {
        const int nb = cur.idx;
        unsigned bm = 1u << nb;
        if (nb > 0) {
            int lane_o = lane; asm volatile("" : "+v"(lane_o));
            const unsigned kmo = (unsigned)((cur.hg * 32 + (lane_o & 31)) * 128 + (lane_o >> 5) * 8) * 2u; const char* kmhb = (const char*)(ws + WS_KMH); const char* kmlb = (const char*)(ws + WS_KML);
            f32x16 gs = f32x16{};
#pragma unroll
            for (int d0 = 0; d0 < 8; ++d0) { const bf16x8 ah = *(const GAS bf16x8*)(kmhb + kmo + d0 * 32), al = *(const GAS bf16x8*)(kmlb + kmo + d0 * 32);
                gs = __builtin_amdgcn_mfma_f32_32x32x16_bf16(ah, S.qr[d0], gs, 0, 0, 0); gs = __builtin_amdgcn_mfma_f32_32x32x16_bf16(al, S.qr[d0], gs, 0, 0, 0); }
            float v[32];
#pragma unroll
            for (int r = 0; r < 16; ++r) { auto rr = __builtin_amdgcn_permlane32_swap(__float_as_uint(gs[r]), __float_as_uint(gs[r]), false, false);
                const float lo = __uint_as_float(rr[0]), hv = __uint_as_float(rr[1]);
                v[(r & 3) + 8 * (r >> 2)] = lo; v[(r & 3) + 8 * (r >> 2) + 4] = hv; }
            float b1 = -__builtin_inff(), b2 = b1, b3 = b1; int i1 = -1, i2 = -1, i3 = -1;
#pragma unroll
            for (int j = 0; j < 32; ++j) { const float x = j < nb ? v[j] : -__builtin_inff();
                if (x > b1) { b3 = b2; i3 = i2; b2 = b1; i2 = i1; b1 = x; i1 = j; } else if (x > b2) { b3 = b2; i3 = i2; b2 = x; i2 = j; } else if (x > b3) { b3 = x; i3 = j; } }
            if (i1 >= 0) bm |= 1u << i1; if (i2 >= 0) bm |= 1u << i2; if (i3 >= 0) bm |= 1u << i3;
        }
#define EXP8(x) ((((x) & 1u) * 0xfu) | ((((x) >> 1) & 1u) * 0xf0u) | ((((x) >> 2) & 1u) * 0xf00u) | ((((x) >> 3) & 1u) * 0xf000u) | ((((x) >> 4) & 1u) * 0xf0000u) | ((((x) >> 5) & 1u) * 0xf00000u) | ((((x) >> 6) & 1u) * 0xf000000u) | ((((x) >> 7) & 1u) * 0xf0000000u))
        sw0 = EXP8(bm & 0xffu); sw1 = EXP8((bm >> 8) & 0xffu); sw2 = EXP8((bm >> 16) & 0xffu); sw3 = EXP8((bm >> 24) & 0xffu);
#undef EXP8
    }
    float m_reg = -1e30f, l_reg = 0; f32x16 o[4] = {f32x16{}, f32x16{}, f32x16{}, f32x16{}};
    const int sr = tid >> 4, sc = (tid & 15) * 8, vst0 = v_st(sr, sc), vst1 = v_st(32 + sr, sc), kws = KSWZ(sr, sc * 2);
    const unsigned roff0 = (unsigned)(sr * ZP + sc) * 2u, roff1 = roff0 + 32u * ZP * 2u;
    const int vb0 = (int)(uintptr_t)V_lds + v_rd_base(lane);
#define RESC(a_) do { if (__any((a_) < 1.f)) { if (hi == 0) al_l[r32] = (a_); asm volatile("s_waitcnt lgkmcnt(0)" ::: "memory");              \
                     for (int r = 0; r < 16; ++r) { const float f_ = al_h[(r & 3) + 8 * (r >> 2)]; for (int d_ = 0; d_ < 4; ++d_) o[d_][r] *= f_; } } } while (0)
#define KBASE(t) ((j_lo + (t)) * KVBLK)
#define MASKT(P0_, P1_, t) do { const int kb_ = KBASE(t); const int jt_ = j_lo + (t);                                                  \
        const unsigned wsel_ = (jt_ < 64) ? ((jt_ < 32) ? sw0 : sw1) : ((jt_ < 96) ? sw2 : sw3); const bool rs_ = (wsel_ >> (jt_ & 31)) & 1u;   \
        if (kb_ + KVBLK - 1 > qlo - 113 || kb_ <= qhi - Wedge) mask_tile(P0_, P1_, qm - kb_, W, rs_, lutp);                                 \
        else if (!__all(rs_)) mask_rows(P0_, P1_, rs_); } while (0)
#define SEAM_K0() do { VMWN(8); SWRITE_HK(0); SBAR(); } while (0)
    f32x16 pA0, pA1, pB0, pB1; float mnA, mnB, alA, alB; bf16x8 pa0, pa1, pa2, pa3;
    SWRITE_HV(0); SBAR();
    if (NT > 1) { SLOAD_H(ko, vo, KBASE(1)); }
    SBAR(); qkt<0>(pA0, pA1, K_lds, r32, hi, S.qr);
    MASKT(pA0, pA1, 0); partialSM(pA0, pA1, m_reg, mnA, alA);
    if (NT > 1) { VMW(); SWRITE_H(1); }
    __syncthreads();
#define HALF_STEP(PX0, PX1, mnX, alX, PY0, PY1, alY, t, KB, VB, SB) do {                                                      \
        SBAR(); qkt<KB>(PX0, PX1, K_lds, r32, hi, S.qr);                                                                      \
        finishSM(PY0, PY1, alY, l_reg, pa0, pa1, pa2, pa3); SBAR();                                                           \
        if ((t) + 1 < NT) { SLOAD_H(ko, vo, KBASE((t) + 1)); SBAR(); }                                                        \
        pv_tile<VB>(o, vb0, pa0, pa1, pa2, pa3); MASKT(PX0, PX1, (t)); partialSM(PX0, PX1, m_reg, mnX, alX);                  \
        __syncthreads();                                                                                                      \
        if ((t) + 1 < NT) { VMW(); SWRITE_H(SB); }                                                                            \
        RESC(alX); __syncthreads(); } while (0)
    for (int t = 1; t + 1 < NT; t += 2) {
        HALF_STEP(pB0, pB1, mnB, alB, pA0, pA1, alA, t, 1, 0, 0);
        HALF_STEP(pA0, pA1, mnA, alA, pB0, pB1, alB, t + 1, 0, 1, 1);
    }
    const bool even = (NT & 1) == 0;
    if (even) { SBAR(); qkt<1>(pB0, pB1, K_lds, r32, hi, S.qr); SBAR(); }
    SLOAD_H(kon, von, kbn); SBAR();
    { const unsigned qoff = (unsigned)(blk_tok(nxt, wid, r32) * ZP + blk_qcol(nxt, r32) + hi * 8) * 2u;
#pragma unroll
      for (int d0 = 0; d0 < 8; ++d0) S.qr[d0] = *(const GAS bf16x8*)((const char*)z + qoff + d0 * 32); }
    SBAR();
    finishSM(pA0, pA1, alA, l_reg, pa0, pa1, pa2, pa3); SBAR();
    pv_tile<0>(o, vb0, pa0, pa1, pa2, pa3);
    if (even) { MASKT(pB0, pB1, NT - 1); partialSM(pB0, pB1, m_reg, mnB, alB); __syncthreads(); RESC(alB);
        finishSM(pB0, pB1, alB, l_reg, pa0, pa1, pa2, pa3); SBAR(); pv_tile<1>(o, vb0, pa0, pa1, pa2, pa3); }
    SBAR(); SEAM_K0();
    if (hi == 0) { float f = __builtin_amdgcn_rcpf(l_reg);
        if (MODE != MODE_MOBA) { const float gl = bf2f(z[(size_t)qpos * ZP + GL_OFF + cur.hg * 12 + (r32 & 3) * 3 + (MODE == MODE_SLC ? 1 : 2)]); f *= __builtin_amdgcn_rcpf(1.f + __builtin_amdgcn_exp2f(-1.4426950408889634f * gl)); }
        li_l[r32] = f; }
    asm volatile("s_waitcnt lgkmcnt(0)" ::: "memory");
    bf16* ocat = (bf16*)(ws + WS_A); const char* onr = (const char*)(MODE == MODE_SLC ? ws + WS_B : ws + WS_ON2); char* onw = (char*)(ws + WS_ON2);
#pragma unroll
    for (int r = 0; r < 16; ++r) { const int orow = crow(r, hi); const float rl = li_h[(r & 3) + 8 * (r >> 2)];
        if (MODE == MODE_MOBA) { bf16* Ow = ocat + (size_t)(qlo + orow) * DM + cur.hg * 128;
#pragma unroll
            for (int d0 = 0; d0 < 4; ++d0) { const float v = o[d0][r] * rl; const float vn = __shfl_xor(v, 1);
                if ((r32 & 1) == 0) *(unsigned*)(Ow + d0 * 32 + r32) = cvtpk(v, vn); } }
        else { const int tok = qlo + (orow >> 2), hh = 4 * cur.hg + (orow & 3); const unsigned oidx = (unsigned)(tok * 1024 + hh * 128 + r32) * 4u;
#pragma unroll
            for (int d0 = 0; d0 < 4; ++d0) { const float v = *(const GAS float*)(onr + oidx + d0 * 128) + o[d0][r] * rl;
                if (MODE == MODE_SLC) *(GAS float*)(onw + oidx + d0 * 128) = v;
                else { bf16* Ow = ocat + (size_t)tok * DM + 1024 + hh * 128; const float vn = __shfl_xor(v, 1); if ((r32 & 1) == 0) *(unsigned*)(Ow + d0 * 32 + r32) = cvtpk(v, vn); } }
            asm volatile("" ::: "memory"); } }
    __syncthreads();
#undef RESC
#undef KBASE
#undef MASKT
#undef SEAM_K0
#undef HALF_STEP
}
__device__ __forceinline__ int item_nblk(int k) { return k < 128 ? 2 : 4; }
__device__ __forceinline__ Blk item_blk(int k, int i) {
    Blk b;
    if (k < 128) { b.mode = MODE_MOBA; b.hg = k & 7; const int s = k >> 3; b.idx = i == 0 ? s : 31 - s; }
    else { const int kk = k - 128, s = kk >> 1; b.hg = kk & 1; b.mode = (i & 1) ? MODE_WIN : MODE_SLC; b.idx = (i < 2) ? s : 127 - s; }
    return b;
}
__device__ __forceinline__ void mixer_att(const Frame& F, const Args& a) {
    char* lds = (char*)F.lds;
    load_lut(F, (const float*)(a.ws + WS_LUT));
    const bf16* z = (const bf16*)(a.ws + WS_C);
    int k = blockIdx.x; if (k >= 256) return;
    int i = 0; Blk cur = item_blk(k, 0); Seam S;
    att_prime(cur, z, lds, S, F.tid);
    for (;;) {
        int kn = k, in = i + 1; bool last = false;
        if (in >= item_nblk(k)) { in = 0; kn = k + F.G; if (kn >= 256) last = true; }
        const Blk nxt = last ? cur : item_blk(kn, in);
        att_block(cur, nxt, a, lds, S, F.tid);
        if (last) break;
        cur = nxt; k = kn; i = in;
    }
}
}
#define MIXER_PRE_A() mx::mixer_pre_a(F, args)
#define MIXER_PRE_B() mx::mixer_pre_b(F, args)
#define MIXER_ATT() mx::mixer_att(F, args)
#define XB_TMO      128
#define XB_XCNT(j)  (256  + 64 * (j))
#define XB_XSUB(j)  (1280 + 64 * (j))
#define XB_XGEN(j)  (2304 + 64 * (j))
#define XB_TOP      3328
#define XB_TOPGEN   3392
#define XCD_BAR_WORDS 3456
#define XB_SPIN_CAP (1u << 18)

__device__ __forceinline__ unsigned xb_ld(unsigned* p)              { return __hip_atomic_load(p, __ATOMIC_RELAXED, __HIP_MEMORY_SCOPE_AGENT); }
__device__ __forceinline__ unsigned xb_add(unsigned* p, unsigned v) { return __hip_atomic_fetch_add(p, v, __ATOMIC_RELAXED, __HIP_MEMORY_SCOPE_AGENT); }
__device__ __forceinline__ unsigned xb_xcc_id() { return (unsigned)__builtin_amdgcn_s_getreg((3 << 11) | 20) & 0xFu; }
#define XB_SPIN(cond, bar) do { unsigned _sp = 0; while (cond) { __builtin_amdgcn_s_sleep(1); \
    if ((++_sp & 255u) == 0u) { if (xb_ld(&(bar)[XB_TMO])) break; if (_sp > XB_SPIN_CAP) { atomicAdd(&(bar)[XB_TMO], 1u); break; } } } } while (0)

struct XcdBarrier {
    unsigned* bar; unsigned x;
    volatile LAS unsigned* st;
};

__device__ __forceinline__ XcdBarrier xcd_barrier_post(unsigned* bar, volatile LAS unsigned* st) {
    XcdBarrier b; b.bar = bar; b.x = xb_xcc_id(); b.st = st;
    if (threadIdx.x == 0) (void)xb_add(&bar[XB_XCNT(b.x)], 1u);
    return b;
}
__device__ __forceinline__ void xcd_barrier_complete(unsigned* bar, unsigned x, unsigned& nloc, unsigned& nx) {
    const unsigned G = gridDim.x * gridDim.y * gridDim.z;
    unsigned sum, cnt, mine, sp = 0u;
    for (;;) {
        sum = 0u; cnt = 0u; mine = 0u;
#pragma unroll
        for (unsigned j = 0; j < 16; ++j) { const unsigned c = xb_ld(&bar[XB_XCNT(j)]); sum += c; cnt += (c > 0u) ? 1u : 0u; mine = (j == x) ? c : mine; }
        if (sum == G) break;
        __builtin_amdgcn_s_sleep(1);
        if ((++sp & 255u) == 0u) { if (xb_ld(&bar[XB_TMO])) break; if (sp > XB_SPIN_CAP) { atomicAdd(&bar[XB_TMO], 1u); break; } }
    }
    nloc = mine > 0u ? mine : 1u; nx = cnt > 0u ? cnt : 1u;
}

__device__ __forceinline__ void xcd_barrier(const XcdBarrier& b) {
    asm volatile("s_waitcnt vmcnt(0)" ::: "memory");
    __syncthreads();
    if (threadIdx.x == 0) {
        unsigned* bar = b.bar;
        __builtin_amdgcn_s_waitcnt(0);
        unsigned nloc = b.st[0], nx = b.st[1];
        if (nloc == 0u) { xcd_barrier_complete(bar, b.x, nloc, nx); b.st[0] = nloc; b.st[1] = nx; }
        const unsigned old = xb_add(&bar[XB_XSUB(b.x)], 1u);
        const unsigned gen = old / nloc;
        if (old + 1u == (gen + 1u) * nloc) {
            __builtin_amdgcn_fence(__ATOMIC_RELEASE, "agent");
            asm volatile("s_waitcnt vmcnt(0)" ::: "memory");
            const unsigned og = xb_add(&bar[XB_TOP], 1u);
            const unsigned tg = og / nx;
            if (og + 1u == (tg + 1u) * nx) xb_add(&bar[XB_TOPGEN], 1u);
            else XB_SPIN(xb_ld(&bar[XB_TOPGEN]) == tg, bar);
            __builtin_amdgcn_fence(__ATOMIC_ACQUIRE, "agent");
            xb_add(&bar[XB_XGEN(b.x)], 1u);
            asm volatile("s_waitcnt vmcnt(0)" ::: "memory");
        } else {
            XB_SPIN(xb_ld(&bar[XB_XGEN(b.x)]) == gen, bar);
            __builtin_amdgcn_fence(__ATOMIC_ACQUIRE, "agent");
            asm volatile("s_waitcnt vmcnt(0)" ::: "memory");
        }
    }
    __syncthreads();
}

__device__ __forceinline__ bool phase_begin(Frame& F) { int t = threadIdx.x; asm volatile("" : "+v"(t)); F.tid = t; F.lane = t & 63; return true; }
#ifndef N_LAUNCHES
#define N_LAUNCHES 1
#endif
#ifndef REP0
#define REP0 1
#endif
#ifndef REP1
#define REP1 1
#endif
#ifndef REP2
#define REP2 1
#endif
#ifndef REP3
#define REP3 1
#endif
#ifndef REP4
#define REP4 1
#endif
#ifndef REP5
#define REP5 1
#endif
#ifndef REP7
#define REP7 1
#endif
#ifndef REPSYNC
#define REPSYNC 0
#endif
constexpr int NPH = 10;
__global__ void __launch_bounds__(NWAVES * 64, 2) fwd_kernel(Args args) {
    extern __shared__ __attribute__((aligned(16))) unsigned char lds_raw[];
    Frame F; F.lds = (LAS unsigned char*)lds_raw; F.tid = threadIdx.x; F.lane = F.tid & 63; F.wave = __builtin_amdgcn_readfirstlane(F.tid >> 6);
    F.G = gridDim.x; F.gw = blockIdx.x * NWAVES + F.wave; F.NGW = F.G * NWAVES;
    unsigned char* ws = args.ws;
    const int lo = args.ph_lo, hi = args.ph_hi;
#ifndef PHMASK
#define PHMASK 0x3ff
#endif
#define IN(k) (((PHMASK >> (k)) & 1) && lo <= (k) && (k) < hi && phase_begin(F))
#if N_LAUNCHES == 1
    cg::grid_group grid = cg::this_grid();
    { volatile LAS unsigned* misc = (volatile LAS unsigned*)(F.lds + MISC_OFF); if (F.tid < 4) misc[F.tid] = 0u; __syncthreads(); }
    const XcdBarrier xbar = xcd_barrier_post((unsigned*)(ws + WS_CTL), (volatile LAS unsigned*)(F.lds + MISC_OFF));
#define GSYNC_CG() do { asm volatile("s_waitcnt vmcnt(0) lgkmcnt(0)" ::: "memory"); grid.sync(); __builtin_amdgcn_fence(__ATOMIC_ACQUIRE, "agent"); asm volatile("s_waitcnt vmcnt(0)" ::: "memory"); } while (0)
#define GSYNC() xcd_barrier(xbar)
#define SEAM(k) do { if (lo <= (k) && (k) + 1 < hi) { if ((k) == 0) GSYNC_CG(); else GSYNC(); } } while (0)
#else
#define SEAM(k) do { } while (0)
#endif
    bf16* const Wt_in = (bf16*)(ws + WS_B); bf16* const xb = (bf16*)(ws + WS_A); bf16* const zb = (bf16*)(ws + WS_C);
    bf16* const ocat = (bf16*)(ws + WS_A); bf16* const GE = (bf16*)(ws + WS_A); bf16* const h1 = (bf16*)(ws + WS_B); bf16* const ub = (bf16*)(ws + WS_C);
    if (IN(0)) { p0_prologue(F, args); }
#if REP0 == 2
    GSYNC_CG(); if (IN(0)) { p0_prologue(F, args); }
#endif
    SEAM(0);
    for (int rep = 0; rep < REPSYNC; ++rep) GSYNC();
    for (int rep = 0; rep < REP1; ++rep) { if (rep) GSYNC();
    if (IN(1)) { pg8::Gemm g{xb, Wt_in, S_, PROJ_PAD, DM}; pg8::StaticOrder S; S.init(S_, PROJ_PAD, F.G, (int)blockIdx.x);
        pg8::EpiBf16<0> E{zb, ZP, PROJ}; pg8::gemm_phase<pg8::EpiBf16<0>, pg8::StaticOrder, true, true>(F.lds, g, S, E, F.tid); } } SEAM(1);
    if (IN(2)) { MIXER_PRE_A(); }
#if REP2 == 2
    GSYNC(); if (IN(2)) { MIXER_PRE_A(); }
#endif
    SEAM(2);
    if (IN(3)) { MIXER_PRE_B(); }
#if REP3 == 2
    GSYNC(); if (IN(3)) { MIXER_PRE_B(); }
#endif
    SEAM(3);
    if (IN(4)) { MIXER_ATT(); }
#if REP4 == 2
    GSYNC(); if (IN(4)) { MIXER_ATT(); }
#endif
    SEAM(4);
    for (int rep = 0; rep < REP5; ++rep) { if (rep) GSYNC();
    if (IN(5)) { pg8::Gemm g{ocat, (bf16*)(ws + WS_WOUT), S_, DM, DM}; pg8::StaticOrder S; S.init(S_, DM, F.G, (int)blockIdx.x);
        pg8::EpiResid E{args.in[0], args.out, DM, DN_ALPHA}; pg8::gemm_phase<pg8::EpiResid, pg8::StaticOrder, true, true>(F.lds, g, S, E, F.tid); } } SEAM(5);
    if (IN(6)) { ln_rows<true>(F, args.out, h1, args.in[11], args.in[12]); } SEAM(6);
    for (int rep = 0; rep < REP7; ++rep) { if (rep) GSYNC();
    if (IN(7)) {
#ifndef NO6A
        { pg8::Gemm g{h1, (bf16*)(ws + WS_WFF1), S_, DFF, DM}; pg8::StaticOrder S; S.init(S_, DFF, F.G, (int)blockIdx.x);
          pg8::EpiBf16<1> E{ub, DFF, DFF}; pg8::gemm_phase<pg8::EpiBf16<1>, pg8::StaticOrder, true, true>(F.lds, g, S, E, F.tid); }
#endif
#ifndef NO6B
        { pg8::Gemm g{h1, (bf16*)(ws + WS_WGATE), S_, DM, DM}; pg8::StaticOrder S; S.init(S_, DM, F.G, (int)blockIdx.x);
          pg8::EpiBf16<2> E{GE, DM, DM}; pg8::gemm_phase<pg8::EpiBf16<2>, pg8::StaticOrder, true, true>(F.lds, g, S, E, F.tid); }
#endif
#ifndef NO6C
        asm volatile("s_waitcnt vmcnt(0)" ::: "memory"); __syncthreads();
        { int kple = DPLE; asm volatile("" : "+s"(kple)); pg8::Gemm g{(bf16*)(ws + WS_PB), (bf16*)(ws + WS_WPLE), S_, DM, kple}; pg8::StaticOrder S; S.init(S_, DM, F.G, (int)blockIdx.x);
          pg8::EpiBf16<3> E{GE, DM, DM}; pg8::gemm_phase<pg8::EpiBf16<3>, pg8::StaticOrder, true, true>(F.lds, g, S, E, F.tid); }
#endif
    } } SEAM(7);
    if (IN(8)) { pg8::Gemm g{ub, (bf16*)(ws + WS_WFF2), S_, DM, DFF}; pg8::StaticOrder S; S.init(S_, DM, F.G, (int)blockIdx.x);
        pg8::EpiFfn2 E{args.out, GE, DM}; pg8::gemm_phase<pg8::EpiFfn2, pg8::StaticOrder, true, true>(F.lds, g, S, E, F.tid); } SEAM(8);
    if (IN(9)) { ln_rows<false>(F, args.out, nullptr, args.in[17], args.in[18]); }
#undef IN
#undef SEAM
}

extern "C" void kernel_launch(void* const* d_in, const int* in_sizes, int n_in, void* d_out, int out_size, void* d_ws, size_t ws_size, hipStream_t stream) {
    static int grid = 0;
    if (grid == 0) {
        if (n_in != 19 || out_size != S_ * DM || ws_size < WS_END) { fprintf(stderr, "kernel_launch: unexpected shapes (n_in %d out %d ws %zu)\n", n_in, out_size, ws_size); grid = -1; return; }
        int dev = 0, cus = 0, per_cu = 0;
        (void)hipGetDevice(&dev); (void)hipDeviceGetAttribute(&cus, hipDeviceAttributeMultiprocessorCount, dev);
        if (hipFuncSetAttribute((const void*)fwd_kernel, hipFuncAttributeMaxDynamicSharedMemorySize, LDS_BYTES) != hipSuccess) { fprintf(stderr, "kernel_launch: hipFuncSetAttribute failed\n"); grid = -1; return; }
        if (hipOccupancyMaxActiveBlocksPerMultiprocessor(&per_cu, (const void*)fwd_kernel, NWAVES * 64, LDS_BYTES) != hipSuccess || per_cu < 1) { fprintf(stderr, "kernel_launch: occupancy query gives %d\n", per_cu); per_cu = 1; }
        (void)hipGetLastError();
        grid = cus * 1;
        if (grid <= 0) grid = 256;
    }
    if (grid < 0) return;
    (void)hipMemsetAsync((char*)d_ws + WS_CTL, 0, 16384, stream);
    Args a{};
    for (int i = 0; i < 19; ++i) a.in[i] = (const float*)d_in[i];
    a.out = (float*)d_out; a.ws = (unsigned char*)d_ws;
#if N_LAUNCHES == 1
    a.ph_lo = 0; a.ph_hi = NPH;
    void* kargs[] = {&a};
    hipError_t e = hipLaunchCooperativeKernel((const void*)fwd_kernel, dim3(grid), dim3(NWAVES * 64), kargs, LDS_BYTES, stream);
    if (e != hipSuccess) fprintf(stderr, "cooperative launch failed: %s (grid %d)\n", hipGetErrorString(e), grid);
#else
    for (int p = 0; p < NPH; ++p) { a.ph_lo = p; a.ph_hi = p + 1; hipLaunchKernelGGL(fwd_kernel, dim3(grid), dim3(NWAVES * 64), LDS_BYTES, stream, a); }
#endif
}
```

```cpp
#include <hip/hip_runtime.h>
#include <hip/hip_cooperative_groups.h>
#include <cstdio>
#include <cstdint>
namespace cg = cooperative_groups;
namespace pg8 {
#define PG8_LAS __attribute__((address_space(3)))
typedef unsigned short bf16_t;
typedef short bf16x8 __attribute__((ext_vector_type(8)));
typedef float f32x4 __attribute__((ext_vector_type(4)));
typedef unsigned u32x4 __attribute__((ext_vector_type(4)));
constexpr int BM = 256, BK = 64, HALF = 128, HTB = HALF * BK * 2  , STAGE_BYTES = 8 * HTB, NXCD = 8, WGM = 8;

__host__ __device__ __forceinline__ int lds_byte(int r, int c) { const int st = (r >> 4) * 2 + (c >> 5), rr = r & 15, cc = c & 31, ob = rr * 64 + cc * 2; return st * 1024 + (ob ^ (((ob >> 9) & 1) << 5)); }
__host__ __device__ __forceinline__ void stage_rc(int b, int& R, int& C) { const int st = b / 1024, sb = b % 1024, swz = sb ^ (((sb >> 9) & 1) << 5); R = (st >> 1) * 16 + swz / 64; C = (st & 1) * 32 + (swz % 64) / 2; }
__host__ __device__ __forceinline__ int perm32(int rho) { const int n = rho >> 4, i = rho & 15; return 8 * (i >> 2) + 4 * n + (i & 3); }

struct Unit { int pm, pn; };
struct Gemm { const bf16_t* A; const bf16_t* Bt; int M, N, K; };

struct StaticOrder {
    int nM, nN, nwg, G, c;
    __host__ __device__ void init(int M, int N, int G_, int c_) { nM = M / BM; nN = N / BM; nwg = nM * nN; G = G_; c = c_; }
    __host__ __device__ bool next(int i, Unit& u) const {
        const long L = (long)i * G + c; if (L >= nwg) return false;
        int wgid = (int)L; { const int q = nwg / NXCD, r = nwg % NXCD, xcd = wgid % NXCD, off = wgid / NXCD; wgid = (xcd < r ? xcd * (q + 1) : r * (q + 1) + (xcd - r) * q) + off; }
        const int nig = WGM * nN, gid = wgid / nig, fm = gid * WGM, gsz = (nM - fm) < WGM ? (nM - fm) : WGM;
        u.pm = fm + ((wgid % nig) % gsz); u.pn = (wgid % nig) / gsz; return true;
    }
    __device__ __forceinline__ void a_ready(const Unit&) const {}
    __device__ __forceinline__ void done(const Unit&) const {}
};

typedef float f32x2_t __attribute__((ext_vector_type(2))); typedef __bf16 bf16x2_t __attribute__((ext_vector_type(2)));
__device__ __forceinline__ unsigned cvt_pk_bf16(float lo, float hi) { f32x2_t v = {lo, hi}; bf16x2_t b = __builtin_convertvector(v, bf16x2_t); return __builtin_bit_cast(unsigned, b); }
__device__ __forceinline__ float bf_lo(unsigned w) { return __uint_as_float(w << 16); }
__device__ __forceinline__ float bf_hi(unsigned w) { return __uint_as_float(w & 0xffff0000u); }
template <int ACT> struct EpiBf16 {
    static constexpr bool PERM = true, AFTER_DRAIN = false;
    bf16_t* O; int ldc; int ncols;
    __device__ __forceinline__ void operator()(const f32x4 (&acc)[2][2][4][2], const Unit& u, int wr, int wc, int fr, int fq) const {
        const int row0 = u.pm * BM + wr * 64 + fr; const int col0 = u.pn * BM + wc * 32 + 8 * fq;
#pragma unroll
        for (int ai = 0; ai < 2; ++ai)
#pragma unroll
            for (int m = 0; m < 4; ++m) { bf16_t* rowp = O + (size_t)(row0 + ai * HALF + m * 16) * ldc + col0;
#pragma unroll
                for (int bj = 0; bj < 2; ++bj) { if (col0 + bj * HALF >= ncols) continue;
                    f32x4 v0 = acc[ai][bj][m][0], v1 = acc[ai][bj][m][1];
                    if (ACT == 1) {
#pragma unroll
                        for (int e = 0; e < 4; ++e) { const float a = fmaxf(v0[e], 0.f), b = fmaxf(v1[e], 0.f); v0[e] = a * a; v1[e] = b * b; } }
                    if (ACT == 2) {
#pragma unroll
                        for (int e = 0; e < 4; ++e) { v0[e] = __builtin_amdgcn_rcpf(1.f + __builtin_amdgcn_exp2f(-1.4426950408889634f * v0[e])); v1[e] = __builtin_amdgcn_rcpf(1.f + __builtin_amdgcn_exp2f(-1.4426950408889634f * v1[e])); } }
                    if (ACT == 3) { const u32x4 g = *(const u32x4*)(rowp + bj * HALF);
                        v0[0] *= bf_lo(g.x); v0[1] *= bf_hi(g.x); v0[2] *= bf_lo(g.y); v0[3] *= bf_hi(g.y); v1[0] *= bf_lo(g.z); v1[1] *= bf_hi(g.z); v1[2] *= bf_lo(g.w); v1[3] *= bf_hi(g.w); }
                    u32x4 w; w.x = cvt_pk_bf16(v0[0], v0[1]); w.y = cvt_pk_bf16(v0[2], v0[3]); w.z = cvt_pk_bf16(v1[0], v1[1]); w.w = cvt_pk_bf16(v1[2], v1[3]);
                    *(u32x4*)(rowp + bj * HALF) = w; }
                if (ACT == 3) asm volatile("" ::: "memory"); }
    }
};
struct EpiResid {
    static constexpr bool PERM = false, AFTER_DRAIN = false;
    const float* X; float* out; int ldc; float alpha;
    __device__ __forceinline__ void operator()(const f32x4 (&acc)[2][2][4][2], const Unit& u, int wr, int wc, int fr, int fq) const {
        const int row0 = u.pm * BM + wr * 64 + fr, col0 = u.pn * BM + wc * 32 + 4 * fq;
#pragma unroll
        for (int ai = 0; ai < 2; ++ai)
#pragma unroll
            for (int m = 0; m < 4; ++m) { const size_t off = (size_t)(row0 + ai * HALF + m * 16) * ldc + col0;
#pragma unroll
                for (int bj = 0; bj < 2; ++bj)
#pragma unroll
                    for (int n = 0; n < 2; ++n) { const f32x4 xv = *(const f32x4*)(X + off + bj * HALF + n * 16); *(f32x4*)(out + off + bj * HALF + n * 16) = xv * alpha + acc[ai][bj][m][n]; } }
    }
};
struct EpiFfn2 {
    static constexpr bool PERM = false, AFTER_DRAIN = false;
    float* out; const bf16_t* E; int ldc;
    __device__ __forceinline__ void operator()(const f32x4 (&acc)[2][2][4][2], const Unit& u, int wr, int wc, int fr, int fq) const {
        typedef unsigned u32x2 __attribute__((ext_vector_type(2)));
        const int row0 = u.pm * BM + wr * 64 + fr, col0 = u.pn * BM + wc * 32 + 4 * fq;
#pragma unroll
        for (int ai = 0; ai < 2; ++ai)
#pragma unroll
            for (int m = 0; m < 4; ++m) { const size_t off = (size_t)(row0 + ai * HALF + m * 16) * ldc + col0;
#pragma unroll
                for (int bj = 0; bj < 2; ++bj)
#pragma unroll
                    for (int n = 0; n < 2; ++n) { const f32x4 xv = *(const f32x4*)(out + off + bj * HALF + n * 16); const u32x2 ev = *(const u32x2*)(E + off + bj * HALF + n * 16);
                        f32x4 o = xv + acc[ai][bj][m][n]; o[0] += bf_lo(ev.x); o[1] += bf_hi(ev.x); o[2] += bf_lo(ev.y); o[3] += bf_hi(ev.y);
                        *(f32x4*)(out + off + bj * HALF + n * 16) = o; } }
    }
};
template <class Epi, class Sched, bool ALIGN_EPI = false, bool SP2 = false>
__device__ __forceinline__ void gemm_phase(PG8_LAS unsigned char* lds, const Gemm g, const Sched& S, const Epi& E, const int tid_in) {
    const int tid = tid_in, wid = __builtin_amdgcn_readfirstlane(tid >> 6), lane = tid & 63, wr = wid >> 2, wc = wid & 3, fr = lane & 15, fq = lane >> 4;
    const int K = g.K, nt = K / BK;
    unsigned voffA[2], voffB[2];
#pragma unroll
    for (int i = 0; i < 2; ++i) { int R, C; stage_rc(tid * 16 + i * 8192, R, C); const int Rb = Epi::PERM ? ((R & ~31) + perm32(R & 31)) : R;
        voffA[i] = (unsigned)(R * K + C) * 2u; voffB[i] = (unsigned)(Rb * K + C) * 2u; }
    const size_t kstep = (size_t)(BK * 2);
    const size_t hstep = (size_t)HALF * K * 2;
    const size_t tstep = 2 * hstep;
    const unsigned ldsw = (unsigned)wid * 1024u;
    const int aoff = lds_byte(wr * 64 + fr, fq * 8), boff = lds_byte(wc * 32 + fr, fq * 8);
#define PG8_SA(b, h) (((b) * 2 + (h)) * HTB)
#define PG8_SB(b, h) ((4 + (b) * 2 + (h)) * HTB)
#define PG8_STAGE(bufoff, gbase, voff) do { _Pragma("unroll") for (int _i = 0; _i < 2; ++_i) \
        __builtin_amdgcn_global_load_lds((const unsigned*)((const char*)(gbase) + (voff)[_i]), (PG8_LAS unsigned*)(lds + (bufoff) + ldsw + _i * 8192), 16, 0, 0); } while (0)
#define PG8_LDA(dst, b, h) do { _Pragma("unroll") for (int m = 0; m < 4; ++m) _Pragma("unroll") for (int k = 0; k < 2; ++k) dst[m][k] = *(const PG8_LAS bf16x8*)(lds + PG8_SA(b, h) + aoff + m * 2048 + k * 1024); } while (0)
#define PG8_LDB(dst, b, h) do { _Pragma("unroll") for (int n = 0; n < 2; ++n) _Pragma("unroll") for (int k = 0; k < 2; ++k) dst[n][k] = *(const PG8_LAS bf16x8*)(lds + PG8_SB(b, h) + boff + n * 2048 + k * 1024); } while (0)
#define PG8_MMA(ai, bj, At, Bt) do { __builtin_amdgcn_s_setprio(1); _Pragma("unroll") for (int m = 0; m < 4; ++m) _Pragma("unroll") for (int n = 0; n < 2; ++n) _Pragma("unroll") for (int k = 0; k < 2; ++k) \
        acc[ai][bj][m][n] = __builtin_amdgcn_mfma_f32_16x16x32_bf16(Bt[n][k], At[m][k], acc[ai][bj][m][n], 0, 0, 0); __builtin_amdgcn_s_setprio(0); } while (0)
#define PG8_WAIT_V(n) asm volatile("s_waitcnt vmcnt(" #n ")" ::: "memory")
#define PG8_WAIT_L(n) asm volatile("s_waitcnt lgkmcnt(" #n ")" ::: "memory")
#define PG8_BAR __builtin_amdgcn_s_barrier()
#define PG8_SCHED __builtin_amdgcn_sched_barrier(0)
    Unit cur, nxt; int ui = 0;
    if (!S.next(0, cur)) return;
    f32x4 acc[2][2][4][2];
#pragma unroll
    for (int a = 0; a < 2; ++a)
#pragma unroll
        for (int b = 0; b < 2; ++b)
#pragma unroll
            for (int m = 0; m < 4; ++m)
#pragma unroll
                for (int n = 0; n < 2; ++n) acc[a][b][m][n] = (f32x4){0.f, 0.f, 0.f, 0.f};
    bf16x8 At[4][2], B0[2][2], B1[2][2];
    const char* cA = (const char*)g.A + (size_t)cur.pm * tstep; const char* cB = (const char*)g.Bt + (size_t)cur.pn * tstep;
    S.a_ready(cur);
    if constexpr (SP2) {
        PG8_STAGE(PG8_SB(0, 0), cB, voffB); PG8_STAGE(PG8_SB(0, 1), cB + hstep, voffB); PG8_STAGE(PG8_SA(0, 0), cA, voffA); PG8_STAGE(PG8_SA(0, 1), cA + hstep, voffA);
        if (wr == 1) PG8_BAR;
        PG8_WAIT_V(2); PG8_BAR;
        PG8_STAGE(PG8_SB(1, 0), cB + kstep, voffB); PG8_STAGE(PG8_SA(1, 0), cA + kstep, voffA); PG8_STAGE(PG8_SB(1, 1), cB + hstep + kstep, voffB);
        PG8_WAIT_V(6); PG8_BAR;
    } else {
        PG8_STAGE(PG8_SB(0, 0), cB, voffB); PG8_STAGE(PG8_SA(0, 0), cA, voffA); PG8_STAGE(PG8_SB(0, 1), cB + hstep, voffB); PG8_STAGE(PG8_SA(0, 1), cA + hstep, voffA);
        if (wr == 1) PG8_BAR;
        PG8_WAIT_V(4); PG8_BAR;
        PG8_STAGE(PG8_SB(1, 0), cB + kstep, voffB); PG8_STAGE(PG8_SA(1, 0), cA + kstep, voffA); PG8_STAGE(PG8_SB(1, 1), cB + hstep + kstep, voffB);
        PG8_WAIT_V(6); PG8_BAR;
    }
    for (;;) {
        const bool has_next = S.next(ui + 1, nxt);
        const char* nA = has_next ? (const char*)g.A + (size_t)nxt.pm * tstep : cA; const char* nB = has_next ? (const char*)g.Bt + (size_t)nxt.pn * tstep : cB;
        for (int t = 0; t < nt; t += 2) {
            const bool last = (t == nt - 2);
            const char* a1 = cA + (size_t)(t + 1) * kstep;
            const char* a2 = last ? nA : cA + (size_t)(t + 2) * kstep; const char* b2 = last ? nB : cB + (size_t)(t + 2) * kstep;
            const char* a3 = a2 + kstep; const char* b3 = b2 + kstep;
            if (last && has_next) S.a_ready(nxt);
            if constexpr (SP2) {
            PG8_LDB(B0, 0, 0); PG8_LDB(B1, 0, 1); PG8_SCHED; PG8_LDA(At, 0, 0); PG8_STAGE(PG8_SA(1, 1), a1 + hstep, voffA);
            PG8_WAIT_V(8); PG8_WAIT_L(0); PG8_BAR; PG8_MMA(0, 0, At, B0); PG8_MMA(0, 1, At, B1); PG8_BAR; PG8_SCHED;
            PG8_LDA(At, 0, 1); PG8_STAGE(PG8_SB(0, 0), b2, voffB); PG8_STAGE(PG8_SB(0, 1), b2 + hstep, voffB); PG8_STAGE(PG8_SA(0, 0), a2, voffA);
            PG8_WAIT_V(8); PG8_WAIT_L(0); PG8_BAR; PG8_MMA(1, 0, At, B0); PG8_MMA(1, 1, At, B1); PG8_BAR; PG8_SCHED;
            PG8_LDB(B0, 1, 0); PG8_LDB(B1, 1, 1); PG8_SCHED; PG8_LDA(At, 1, 0); PG8_STAGE(PG8_SA(0, 1), a2 + hstep, voffA);
            PG8_WAIT_V(8); PG8_WAIT_L(0); PG8_BAR; PG8_MMA(0, 0, At, B0); PG8_MMA(0, 1, At, B1); PG8_BAR; PG8_SCHED;
            PG8_LDA(At, 1, 1); PG8_STAGE(PG8_SB(1, 0), b3, voffB); PG8_STAGE(PG8_SB(1, 1), b3 + hstep, voffB); PG8_STAGE(PG8_SA(1, 0), a3, voffA);
            PG8_WAIT_V(8); PG8_WAIT_L(0); PG8_BAR; PG8_MMA(1, 0, At, B0); PG8_MMA(1, 1, At, B1); PG8_BAR; PG8_SCHED;
            } else {
            PG8_LDB(B0, 0, 0); PG8_SCHED; PG8_LDA(At, 0, 0); PG8_STAGE(PG8_SA(1, 1), a1 + hstep, voffA);
            PG8_WAIT_L(8); PG8_BAR; PG8_WAIT_L(0); PG8_MMA(0, 0, At, B0); PG8_BAR; PG8_SCHED;
            PG8_LDB(B1, 0, 1); PG8_STAGE(PG8_SB(0, 0), b2, voffB);
            PG8_BAR; PG8_WAIT_L(0); PG8_MMA(0, 1, At, B1); PG8_BAR;
            PG8_LDA(At, 0, 1); PG8_STAGE(PG8_SA(0, 0), a2, voffA);
            PG8_BAR; PG8_WAIT_L(0); PG8_MMA(1, 0, At, B0); PG8_BAR; PG8_SCHED;
            PG8_STAGE(PG8_SB(0, 1), b2 + hstep, voffB);
            PG8_WAIT_V(6); PG8_BAR; PG8_MMA(1, 1, At, B1); PG8_BAR;
            PG8_LDB(B0, 1, 0); PG8_SCHED; PG8_LDA(At, 1, 0); PG8_STAGE(PG8_SA(0, 1), a2 + hstep, voffA);
            PG8_WAIT_L(8); PG8_BAR; PG8_WAIT_L(0); PG8_MMA(0, 0, At, B0); PG8_BAR; PG8_SCHED;
            PG8_LDB(B1, 1, 1); PG8_STAGE(PG8_SB(1, 0), b3, voffB);
            PG8_BAR; PG8_WAIT_L(0); PG8_MMA(0, 1, At, B1); PG8_BAR;
            PG8_LDA(At, 1, 1); PG8_STAGE(PG8_SA(1, 0), a3, voffA);
            PG8_BAR; PG8_WAIT_L(0); PG8_MMA(1, 0, At, B0); PG8_BAR; PG8_SCHED;
            PG8_STAGE(PG8_SB(1, 1), b3 + hstep, voffB);
            PG8_WAIT_V(6); PG8_BAR; PG8_MMA(1, 1, At, B1); PG8_BAR;
            }
        }
        if constexpr (ALIGN_EPI) { if (wr == 0) PG8_BAR; }
        if constexpr (!Epi::AFTER_DRAIN) { E(acc, cur, wr, wc, fr, fq); S.done(cur); }
        if (!has_next) break;
#pragma unroll
        for (int a = 0; a < 2; ++a)
#pragma unroll
            for (int b = 0; b < 2; ++b)
#pragma unroll
                for (int m = 0; m < 4; ++m)
#pragma unroll
                    for (int n = 0; n < 2; ++n) acc[a][b][m][n] = (f32x4){0.f, 0.f, 0.f, 0.f};
        cur = nxt; cA = nA; cB = nB; ++ui;
        if constexpr (ALIGN_EPI) { if (wr == 1) PG8_BAR; }
    }
    PG8_WAIT_V(0);
    if constexpr (!ALIGN_EPI) { if (wr == 0) PG8_BAR; }
    PG8_BAR;
    if constexpr (Epi::AFTER_DRAIN) { E.fused(acc, cur, wr, wc, fr, fq, lds, wid, lane); S.done(cur); }
#undef PG8_SA
#undef PG8_SB
#undef PG8_STAGE
#undef PG8_LDA
#undef PG8_LDB
#undef PG8_MMA
#undef PG8_WAIT_V
#undef PG8_WAIT_L
#undef PG8_BAR
#undef PG8_SCHED
}
}
constexpr int S_ = 8192, DM = 2048, DFF = 8192, DPLE = 256, PROJ = 5656, PROJ_PAD = 5888, ZP = PROJ;
constexpr int MQ_OFF = 0, MK_OFF = 1024, MV_OFF = 2048, NQ_OFF = 3072, CK_OFF = 4096, CV_OFF = 4352, SK_OFF = 4608, SV_OFF = 4864, WK_OFF = 5120, WV_OFF = 5376, GL_OFF = 5632;
constexpr float LN_EPS = 1e-5f;
constexpr float DN_ALPHA = 1.189207115002721f;
constexpr int NWAVES = 8;
constexpr size_t MiB = 1u << 20;
constexpr size_t WS_CTL = 0;
constexpr size_t WS_LUT = 1 * MiB;
constexpr size_t WS_KMH = WS_LUT + 8192;
constexpr size_t WS_KML = WS_KMH + 65536;
constexpr size_t WS_KC  = WS_KML + 65536;
constexpr size_t WS_VCT = WS_KC + 262144;
constexpr size_t WS_SEL = WS_VCT + 262144;
constexpr size_t WS_W2T = WS_SEL + 262144;
constexpr size_t WS_CC  = WS_W2T + 65536;
constexpr size_t WS_WOUT = 2 * MiB, WS_WFF1 = 10 * MiB, WS_WFF2 = 42 * MiB, WS_WGATE = 74 * MiB, WS_WPLE = 82 * MiB;
constexpr size_t WS_PB = 83 * MiB;
constexpr size_t WS_A = 87 * MiB;
constexpr size_t WS_B = 119 * MiB;
constexpr size_t WS_W1T = WS_B + 23 * MiB;
constexpr size_t WS_C = 151 * MiB;
constexpr size_t WS_ON2 = WS_C + 89 * MiB;
constexpr size_t WS_END = 279 * MiB;
static_assert(WS_CC + 1024 <= WS_WOUT && (size_t)S_ * ZP * 2 <= 128 * MiB, "ws map");
constexpr int RING_BYTES = 131072, LDS_BYTES = 147456, MISC_OFF = 141312;
#define GAS __attribute__((address_space(1)))
#define LAS __attribute__((address_space(3)))
typedef unsigned short bf16;
typedef unsigned v4u __attribute__((ext_vector_type(4)));
typedef float f32x4 __attribute__((ext_vector_type(4)));
__device__ __forceinline__ unsigned f2bf(float f) { unsigned u = __builtin_bit_cast(unsigned, f); return (u + 0x7fffu + ((u >> 16) & 1u)) >> 16; }
__device__ __forceinline__ unsigned pk2(float lo, float hi) { return f2bf(lo) | (f2bf(hi) << 16); }
#define LDS_WAIT() asm volatile("s_waitcnt lgkmcnt(0)" ::: "memory")
__device__ __forceinline__ float wave_sum(float v) {
#pragma unroll
    for (int o = 1; o < 64; o <<= 1) v += __shfl_xor(v, o);
    return v;
}
__device__ __forceinline__ void p0_tr_load(const float* W, int K, int N, int item, int tid, f32x4 (&v)[8]) {
    const int nblk = (N + 255) / 256, kb = item / nblk, nb = item % nblk, k0 = 64 * kb, n0 = 256 * nb;
    const int n = n0 + (tid & 63) * 4, kr = tid >> 6; const bool ok = n < N;
#pragma unroll
    for (int i = 0; i < 8; ++i) v[i] = ok ? *(const GAS f32x4*)(W + (size_t)(k0 + kr + 8 * i) * N + n) : (f32x4){0.f, 0.f, 0.f, 0.f};
}
__device__ __forceinline__ void p0_tr_store(int K, int N, bf16* WT, LAS float* scr, int item, int tid, const f32x4 (&v)[8]) {
    const int nblk = (N + 255) / 256, kb = item / nblk, nb = item % nblk, k0 = 64 * kb, n0 = 256 * nb;
    const int nl = (tid & 63) * 4, kr = tid >> 6;
#pragma unroll
    for (int i = 0; i < 8; ++i) { LAS float* d = scr + (kr + 8 * i) * 257 + nl; d[0] = v[i][0]; d[1] = v[i][1]; d[2] = v[i][2]; d[3] = v[i][3]; }
    __syncthreads();
    const int c = tid & 7;
#pragma unroll
    for (int j = 0; j < 4; ++j) { const int n = (tid >> 3) + 64 * j; const LAS float* s = scr + (8 * c) * 257 + n;
        v4u o; o.x = pk2(s[0 * 257], s[1 * 257]); o.y = pk2(s[2 * 257], s[3 * 257]); o.z = pk2(s[4 * 257], s[5 * 257]); o.w = pk2(s[6 * 257], s[7 * 257]);
        if (n0 + n < N) *(GAS v4u*)(WT + (size_t)(n0 + n) * K + k0 + 8 * c) = o; }
    __syncthreads();
}
__device__ __forceinline__ int t5_bucket(int n) {
    if (n < 16) return n;
    int b = 16;
    b += (n >= 19); b += (n >= 21); b += (n >= 24); b += (n >= 27); b += (n >= 31); b += (n >= 35); b += (n >= 40); b += (n >= 46);
    b += (n >= 52); b += (n >= 59); b += (n >= 67); b += (n >= 77); b += (n >= 87); b += (n >= 99); b += (n >= 113);
    return b;
}
struct Args { const float* in[19]; float* out; unsigned char* ws; int ph_lo, ph_hi; };
struct Frame {
    LAS unsigned char* lds; int tid, lane, wave, G, gw, NGW;
};
__device__ __forceinline__ void cvt_rows(const float* src, bf16* dst, size_t n8, int gt, int NGT) {
    size_t i = gt;
    for (; i + 3 * (size_t)NGT < n8; i += 4 * (size_t)NGT) { f32x4 a[4], b[4];
#pragma unroll
        for (int u = 0; u < 4; ++u) { a[u] = *(const GAS f32x4*)(src + (i + u * (size_t)NGT) * 8); b[u] = *(const GAS f32x4*)(src + (i + u * (size_t)NGT) * 8 + 4); }
#pragma unroll
        for (int u = 0; u < 4; ++u) { v4u o; o.x = pk2(a[u][0], a[u][1]); o.y = pk2(a[u][2], a[u][3]); o.z = pk2(b[u][0], b[u][1]); o.w = pk2(b[u][2], b[u][3]); *(GAS v4u*)(dst + (i + u * (size_t)NGT) * 8) = o; } }
    for (; i < n8; i += NGT) { const f32x4 a = *(const GAS f32x4*)(src + i * 8), b = *(const GAS f32x4*)(src + i * 8 + 4);
        v4u o; o.x = pk2(a[0], a[1]); o.y = pk2(a[2], a[3]); o.z = pk2(b[0], b[1]); o.w = pk2(b[2], b[3]); *(GAS v4u*)(dst + i * 8) = o; }
}
__device__ __forceinline__ void p0_prologue(const Frame& F, const Args& a) {
    unsigned char* ws = a.ws;
    LAS float* scr = (LAS float*)F.lds;
#define NIT(K_, N_) (((K_) / 64) * (((N_) + 255) / 256))
    constexpr int I0 = NIT(DM, PROJ), I1 = I0 + NIT(DM, DM), I2 = I1 + NIT(DM, DFF), I3 = I2 + NIT(DFF, DM), I4 = I3 + NIT(DM, DM), I5 = I4 + NIT(DPLE, DM), I6 = I5 + NIT(4096, 128), I7 = I6 + NIT(4096, 128), I8 = I7 + NIT(128, 128), I9 = I8 + NIT(128, 128);
#undef NIT
#define TSEL(it_, W_, K_, N_, WT_, loc_) do { \
        if ((it_) < I0) { W_ = a.in[2]; K_ = DM; N_ = PROJ; WT_ = (bf16*)(ws + WS_B); loc_ = (it_); } \
        else if ((it_) < I1) { W_ = a.in[10]; K_ = DM; N_ = DM; WT_ = (bf16*)(ws + WS_WOUT); loc_ = (it_) - I0; } \
        else if ((it_) < I2) { W_ = a.in[13]; K_ = DM; N_ = DFF; WT_ = (bf16*)(ws + WS_WFF1); loc_ = (it_) - I1; } \
        else if ((it_) < I3) { W_ = a.in[14]; K_ = DFF; N_ = DM; WT_ = (bf16*)(ws + WS_WFF2); loc_ = (it_) - I2; } \
        else if ((it_) < I4) { W_ = a.in[16]; K_ = DM; N_ = DM; WT_ = (bf16*)(ws + WS_WGATE); loc_ = (it_) - I3; } \
        else if ((it_) < I5) { W_ = a.in[15]; K_ = DPLE; N_ = DM; WT_ = (bf16*)(ws + WS_WPLE); loc_ = (it_) - I4; } \
        else if ((it_) < I6) { W_ = a.in[4]; K_ = 4096; N_ = 128; WT_ = (bf16*)(ws + WS_W1T); loc_ = (it_) - I5; } \
        else if ((it_) < I7) { W_ = a.in[7]; K_ = 4096; N_ = 128; WT_ = (bf16*)(ws + WS_W1T) + 128 * 4096; loc_ = (it_) - I6; } \
        else if ((it_) < I8) { W_ = a.in[5]; K_ = 128; N_ = 128; WT_ = (bf16*)(ws + WS_W2T); loc_ = (it_) - I7; } \
        else { W_ = a.in[8]; K_ = 128; N_ = 128; WT_ = (bf16*)(ws + WS_W2T) + 128 * 128; loc_ = (it_) - I8; } } while (0)
    {
        f32x4 v[8]; const float* W; int K, N, loc; bf16* WT;
        int it = blockIdx.x;
        if (it < I9) { TSEL(it, W, K, N, WT, loc); p0_tr_load(W, K, N, loc, F.tid, v); }
        while (it < I9) {
            const int K0 = K, N0 = N, loc0 = loc; bf16* const WT0 = WT;
            f32x4 cur[8];
#pragma unroll
            for (int i = 0; i < 8; ++i) cur[i] = v[i];
            const int itn = it + F.G;
            if (itn < I9) { TSEL(itn, W, K, N, WT, loc); p0_tr_load(W, K, N, loc, F.tid, v); }
            p0_tr_store(K0, N0, WT0, scr, loc0, F.tid, cur);
            it = itn;
        }
    }
#undef TSEL
    const int gt = F.gw * 64 + F.lane, NGT = F.NGW * 64;
    cvt_rows(a.in[0], (bf16*)(ws + WS_A), (size_t)S_ * DM / 8, gt, NGT);
    cvt_rows(a.in[1], (bf16*)(ws + WS_PB), (size_t)S_ * DPLE / 8, gt, NGT);
    if (blockIdx.x == 0) {
        float* lut = (float*)(ws + WS_LUT); const float* rb = a.in[9];
        for (int i = F.tid; i < 16 * 128; i += 512) { const int h = i >> 7, d = i & 127; lut[i] = (rb[t5_bucket(d) * 16 + h] - rb[31 * 16 + h]) * 11.313708498984761f; }
    }
}
template <bool FIRST> __device__ __forceinline__ void ln_rows(const Frame& F, const float* in, float* io, bf16* hb, const float* g, const float* b) {
    for (int m = F.gw; m < S_; m += F.NGW) {
        GAS f32x4* xr = (GAS f32x4*)(io + (size_t)m * DM) + F.lane; const GAS f32x4* xi = (const GAS f32x4*)(in + (size_t)m * DM) + F.lane;
        f32x4 v[8]; float s = 0.f;
#pragma unroll
        for (int j = 0; j < 8; ++j) { v[j] = xi[64 * j]; s += (v[j][0] + v[j][1]) + (v[j][2] + v[j][3]); }
        const float mean = wave_sum(s) * (1.f / DM); float s2 = 0.f;
#pragma unroll
        for (int j = 0; j < 8; ++j) { v[j] = v[j] - mean; s2 += (v[j][0] * v[j][0] + v[j][1] * v[j][1]) + (v[j][2] * v[j][2] + v[j][3] * v[j][3]); }
        const float rstd = 1.f / sqrtf(wave_sum(s2) * (1.f / DM) + LN_EPS);
#pragma unroll
        for (int j = 0; j < 8; ++j) { const f32x4 gg = *((const GAS f32x4*)g + F.lane + 64 * j), bb = *((const GAS f32x4*)b + F.lane + 64 * j);
            const f32x4 o = v[j] * rstd * gg + bb;
            if (FIRST) { xr[64 * j] = o * DN_ALPHA; typedef unsigned u32x2 __attribute__((ext_vector_type(2))); u32x2 w; w.x = pk2(o[0], o[1]); w.y = pk2(o[2], o[3]);
                *((GAS u32x2*)(hb + (size_t)m * DM) + F.lane + 64 * j) = w; }
            else xr[64 * j] = o; }
    }
}
namespace mx {
typedef short bf16x8 __attribute__((ext_vector_type(8)));
typedef float f32x16 __attribute__((ext_vector_type(16)));
typedef unsigned u32x4 __attribute__((ext_vector_type(4)));
typedef float f32x2_t __attribute__((ext_vector_type(2))); typedef __bf16 bf16x2_t __attribute__((ext_vector_type(2)));
__device__ __forceinline__ unsigned cvtpk(float lo, float hi) { f32x2_t v = {lo, hi}; bf16x2_t b = __builtin_convertvector(v, bf16x2_t); return __builtin_bit_cast(unsigned, b); }
__device__ __forceinline__ bf16x8 pack8(f32x4 a, f32x4 b) { u32x4 w = {cvtpk(a[0], a[1]), cvtpk(a[2], a[3]), cvtpk(b[0], b[1]), cvtpk(b[2], b[3])}; return __builtin_bit_cast(bf16x8, w); }
__device__ __forceinline__ float bf2f(unsigned short h) { return __uint_as_float((unsigned)h << 16); }
__device__ __forceinline__ int crow(int r, int hi) { return (r & 3) + 8 * (r >> 2) + 4 * hi; }

__device__ __forceinline__ void kmean_item(const Frame& F, const bf16* z, int h, int j, bf16* kmh, bf16* kml) {
    LAS float* red = (LAS float*)F.lds;
    const int cgp = F.tid & 15, rg = F.tid >> 4; float a[8] = {0.f, 0.f, 0.f, 0.f, 0.f, 0.f, 0.f, 0.f};
#pragma unroll
    for (int i = 0; i < 8; ++i) { const v4u w = *(const GAS v4u*)(z + (size_t)(256 * j + rg * 8 + i) * ZP + MK_OFF + h * 128 + cgp * 8);
        a[0] += __uint_as_float(w.x << 16); a[1] += __uint_as_float(w.x & 0xffff0000u); a[2] += __uint_as_float(w.y << 16); a[3] += __uint_as_float(w.y & 0xffff0000u);
        a[4] += __uint_as_float(w.z << 16); a[5] += __uint_as_float(w.z & 0xffff0000u); a[6] += __uint_as_float(w.w << 16); a[7] += __uint_as_float(w.w & 0xffff0000u); }
#pragma unroll
    for (int i = 0; i < 8; ++i) red[rg * 128 + cgp * 8 + i] = a[i];
    __syncthreads();
    if (F.tid < 128) { float s = 0.f;
#pragma unroll 8
        for (int r = 0; r < 32; ++r) s += red[r * 128 + F.tid];
        s *= (1.f / 256.f); const unsigned hb = f2bf(s); const float hf = __uint_as_float(hb << 16);
        kmh[(h * 32 + j) * 128 + F.tid] = (bf16)hb; kml[(h * 32 + j) * 128 + F.tid] = (bf16)f2bf(s - hf); }
    __syncthreads();
}
__device__ __forceinline__ void compress_item(const Frame& F, const bf16* z, int col_off, const bf16* w1T, const bf16* w2T, const float* pe, int rgp, int kv, bf16* kc, bf16* vcT) {
    const int lane = F.lane, r32 = lane & 31, hi = lane >> 5, w = F.wave;
    const int rho = 32 * rgp + r32, n = rho >> 1, g = rho & 1; const int nn = n > 510 ? 510 : n;
    f32x16 acc[4];
#pragma unroll
    for (int eb = 0; eb < 4; ++eb) acc[eb] = f32x16{};
#pragma unroll 1
    for (int ll = 0; ll < 4; ++ll) { const int l = 4 * w + ll; const bf16* arow = z + (size_t)(16 * nn + l) * ZP + col_off + g * 128 + hi * 8;
#pragma unroll
        for (int dd = 0; dd < 8; ++dd) { const u32x4 ar = *(const GAS u32x4*)(arow + dd * 16); const int k0 = l * 128 + dd * 16 + hi * 8;
            const f32x4 pe0 = *(const GAS f32x4*)(pe + k0), pe1 = *(const GAS f32x4*)(pe + k0 + 4);
            const f32x4 x0 = {__uint_as_float(ar.x << 16) + pe0[0], __uint_as_float(ar.x & 0xffff0000u) + pe0[1], __uint_as_float(ar.y << 16) + pe0[2], __uint_as_float(ar.y & 0xffff0000u) + pe0[3]};
            const f32x4 x1 = {__uint_as_float(ar.z << 16) + pe1[0], __uint_as_float(ar.z & 0xffff0000u) + pe1[1], __uint_as_float(ar.w << 16) + pe1[2], __uint_as_float(ar.w & 0xffff0000u) + pe1[3]};
            const bf16x8 a = pack8(x0, x1);
#pragma unroll
            for (int eb = 0; eb < 4; ++eb) { const bf16x8 b = *(const GAS bf16x8*)(w1T + (size_t)(eb * 32 + r32) * 4096 + k0);
                acc[eb] = __builtin_amdgcn_mfma_f32_32x32x16_bf16(a, b, acc[eb], 0, 0, 0); } } }
    LAS float* part = (LAS float*)F.lds;
#pragma unroll
    for (int eb = 0; eb < 4; ++eb)
#pragma unroll
        for (int r = 0; r < 16; ++r) part[(w * 32 + crow(r, hi)) * 128 + eb * 32 + r32] = acc[eb][r];
    __syncthreads();
    for (int i = F.tid; i < 32 * 128; i += 512) { float s = 0.f;
#pragma unroll
        for (int p = 0; p < 8; ++p) s += part[p * 4096 + i];
        const float y = 0.7978845608028654f * (s + 0.044715f * s * s * s); const float t = 1.f - 2.f / (1.f + __expf(2.f * y));
        part[i] = 0.5f * s * (1.f + t); }
    __syncthreads();
    if (w < 4) {
        f32x16 o = f32x16{};
#pragma unroll
        for (int kk = 0; kk < 8; ++kk) { const LAS float* hp = part + r32 * 128 + kk * 16 + hi * 8; const f32x4 x0 = *(const LAS f32x4*)hp, x1 = *(const LAS f32x4*)(hp + 4);
            const bf16x8 a = pack8(x0, x1); const bf16x8 b = *(const GAS bf16x8*)(w2T + (size_t)(w * 32 + r32) * 128 + kk * 16 + hi * 8);
            o = __builtin_amdgcn_mfma_f32_32x32x16_bf16(a, b, o, 0, 0, 0); }
#pragma unroll
        for (int r = 0; r < 16; ++r) { const int row = crow(r, hi), rr = 32 * rgp + row, n2 = rr >> 1, g2 = rr & 1, f = w * 32 + r32;
            const float v = n2 <= 510 ? o[r] : 0.f;
            (kv == 0 ? kc : vcT)[(size_t)(g2 * 512 + n2) * 128 + f] = (bf16)f2bf(v); }
    }
    __syncthreads();
}
__device__ __forceinline__ void mixer_pre_a(const Frame& F, const Args& a) {
    unsigned char* ws = a.ws; const bf16* z = (const bf16*)(ws + WS_C);
    for (int it = blockIdx.x; it < 64 + 256; it += F.G) {
        if (it < 64) { const int kv = it & 1, rgp = it >> 1;
            compress_item(F, z, kv ? CV_OFF : CK_OFF, (const bf16*)(ws + WS_W1T) + (size_t)kv * 128 * 4096, (const bf16*)(ws + WS_W2T) + kv * 128 * 128, kv ? a.in[6] : a.in[3], rgp, kv, (bf16*)(ws + WS_KC), (bf16*)(ws + WS_VCT)); }
        else { const int k = it - 64; kmean_item(F, z, k & 7, k >> 3, (bf16*)(ws + WS_KMH), (bf16*)(ws + WS_KML)); }
    }
}
}
namespace mx {
constexpr float SM_SCALE = 0.08838834764831845f;
constexpr float C2 = 1.4426950408889634f * SM_SCALE;
constexpr int IMP_OFF = 67584;
constexpr int LUT_OFF = 133120;
#define PK4(P, B_, OUT) do { unsigned a0 = cvtpk(P[B_+0], P[B_+1]), a1 = cvtpk(P[B_+2], P[B_+3]);                          \
        unsigned b0 = cvtpk(P[B_+4], P[B_+5]), b1 = cvtpk(P[B_+6], P[B_+7]);                                             \
        auto r0 = __builtin_amdgcn_permlane32_swap(a0, b0, false, false); auto r1 = __builtin_amdgcn_permlane32_swap(a1, b1, false, false); \
        u32x4 w = {r0[0], r1[0], r0[1], r1[1]}; OUT = __builtin_bit_cast(bf16x8, w); } while (0)
__device__ __forceinline__ void load_lut(const Frame& F, const float* lut_g) {
    LAS float* lut = (LAS float*)(F.lds + LUT_OFF);
    for (int i = F.tid; i < 16 * 128; i += 512) lut[i] = lut_g[i];
    __syncthreads();
}
}
namespace mx {
constexpr int NW = 8, QBLK = 32, KVBLK = 64, HD = 128;
constexpr int SHM_V = KVBLK * HD * 2, SHM_K = KVBLK * HD * 2;
constexpr float THR = 8.f;
typedef short s16x4 __attribute__((ext_vector_type(4)));
#define KSWZ(row, colB) ((row) * 256 + ((colB) ^ (((row) & 7) << 4)))
#define SBAR() __builtin_amdgcn_sched_barrier(0)
__device__ __forceinline__ int v_st(int k, int c) { const int kk = (k & ~0xC) | ((k & 4) << 1) | ((k & 8) >> 1); return ((kk >> 3) * 4 + (c >> 5)) * 512 + ((kk & 7) * 32 + (c & 31)) * 2; }
__device__ __forceinline__ int v_rd_base(int lane) { return ((lane & 3) << 3) | (((lane >> 2) & 3) << 6) | (((lane >> 4) & 1) << 5) | (((lane >> 5) & 1) << 8); }
constexpr int v_rd_off(int d0, int ks, int half) { return d0 * 512 + ks * 4096 + half * 2048; }
enum { MODE_MOBA = 0, MODE_SLC = 1, MODE_WIN = 2, MODE_CMP = 3 };
__device__ __forceinline__ void mask_tile(f32x16& p0, f32x16& p1, int dq, int cs, unsigned W, bool rowsel, const LAS float* lutp) {
    const float NEG = -__builtin_inff();
#pragma unroll
    for (int r4 = 0; r4 < 16; r4 += 4) {
#pragma unroll
        for (int r = r4; r < r4 + 4; ++r) { const int c = (r & 3) + 8 * (r >> 2); const int d0 = dq - cs * c, d1 = d0 - cs * 32;
            const float b0 = lutp[min((unsigned)d0, 127u)], b1 = lutp[min((unsigned)d1, 127u)];
            p0[r] = (rowsel && (unsigned)d0 < W) ? p0[r] + b0 : NEG; p1[r] = (rowsel && (unsigned)d1 < W) ? p1[r] + b1 : NEG; }
        asm volatile("" ::: "memory"); }
}
__device__ __forceinline__ void mask_rows(f32x16& p0, f32x16& p1, bool rowsel) {
    const float NEG = -__builtin_inff();
#pragma unroll
    for (int r = 0; r < 16; ++r) { p0[r] = rowsel ? p0[r] : NEG; p1[r] = rowsel ? p1[r] : NEG; }
}
__device__ __forceinline__ void partialSM(f32x16& p0, f32x16& p1, float& m_reg, float& mn, float& alpha) {
    float pmax = p0[0];
#pragma unroll
    for (int r = 1; r < 16; ++r) pmax = fmaxf(pmax, p0[r]);
#pragma unroll
    for (int r = 0; r < 16; ++r) pmax = fmaxf(pmax, p1[r]);
    { auto rr = __builtin_amdgcn_permlane32_swap(__float_as_uint(pmax), __float_as_uint(pmax), false, false);
      pmax = fmaxf(__uint_as_float(rr[0]), __uint_as_float(rr[1])); }
    if (__builtin_expect(__all((pmax - m_reg) * SM_SCALE <= THR), 1)) { mn = m_reg; alpha = 1.f; }
    else { mn = fmaxf(m_reg, pmax); alpha = __builtin_amdgcn_exp2f((m_reg - mn) * C2); m_reg = mn; }
    const float mnL = -mn * C2;
#pragma unroll
    for (int r = 0; r < 16; ++r) p0[r] = fmaf(p0[r], C2, mnL);
#pragma unroll
    for (int r = 0; r < 16; ++r) p1[r] = fmaf(p1[r], C2, mnL);
#pragma unroll
    for (int r = 0; r < 16; ++r) p0[r] = __builtin_amdgcn_exp2f(p0[r]);
}
__device__ __forceinline__ void finishSM(f32x16& p0, f32x16& p1, float alpha, float& l_reg, bf16x8& pa0, bf16x8& pa1, bf16x8& pa2, bf16x8& pa3) {
#pragma unroll
    for (int r = 0; r < 16; ++r) p1[r] = __builtin_amdgcn_exp2f(p1[r]);
    float ps = 0;
#pragma unroll
    for (int r = 0; r < 16; ++r) ps += p0[r];
#pragma unroll
    for (int r = 0; r < 16; ++r) ps += p1[r];
    { auto rr = __builtin_amdgcn_permlane32_swap(__float_as_uint(ps), __float_as_uint(ps), false, false);
      ps = __uint_as_float(rr[0]) + __uint_as_float(rr[1]); }
    l_reg = l_reg * alpha + ps;
    PK4(p0, 0, pa0); PK4(p0, 8, pa1); PK4(p1, 0, pa2); PK4(p1, 8, pa3);
}
template <int KB>
__device__ __forceinline__ void qkt(f32x16& p0, f32x16& p1, const char* K_lds, int r32, int hi, const bf16x8* qr) {
    p0 = f32x16{}; p1 = f32x16{};
    const char* kb[4];
#pragma unroll
    for (int dd = 0; dd < 4; ++dd) kb[dd] = K_lds + KB * SHM_K + KSWZ(r32, (dd * 16 + hi * 8) * 2);
#pragma unroll
    for (int d0 = 0; d0 < 8; ++d0) { const char* a = kb[d0 & 3] + (d0 >> 2) * 128;
        bf16x8 b0 = *reinterpret_cast<const bf16x8*>(a);
        bf16x8 b1 = *reinterpret_cast<const bf16x8*>(a + 32 * 256);
        p0 = __builtin_amdgcn_mfma_f32_32x32x16_bf16(b0, qr[d0], p0, 0, 0, 0);
        p1 = __builtin_amdgcn_mfma_f32_32x32x16_bf16(b1, qr[d0], p1, 0, 0, 0); }
}
template <int VB>
__device__ __forceinline__ void pv_tile(f32x16* o, int vb0, bf16x8 pa0, bf16x8 pa1, bf16x8 pa2, bf16x8 pa3) {
#define TRRD(dst, off) asm volatile("ds_read_b64_tr_b16 %0, %1 offset:%2" : "=&v"(dst) : "v"(vb0), "i"(off) : "memory")
#define PV_D0(d0) do { s16x4 l0, l1, l2, l3, h0, h1, h2, h3; constexpr int b_ = VB * SHM_V + v_rd_off(d0, 0, 0); \
        TRRD(l0, b_); TRRD(h0, b_ + 2048); TRRD(l1, b_ + 4096); TRRD(h1, b_ + 6144); TRRD(l2, b_ + 8192); TRRD(h2, b_ + 10240); TRRD(l3, b_ + 12288); TRRD(h3, b_ + 14336); \
        asm volatile("s_waitcnt lgkmcnt(0)" ::: "memory"); SBAR(); \
        o[d0] = __builtin_amdgcn_mfma_f32_32x32x16_bf16(pa0, (bf16x8){l0[0], l0[1], l0[2], l0[3], h0[0], h0[1], h0[2], h0[3]}, o[d0], 0, 0, 0);   \
        o[d0] = __builtin_amdgcn_mfma_f32_32x32x16_bf16(pa1, (bf16x8){l1[0], l1[1], l1[2], l1[3], h1[0], h1[1], h1[2], h1[3]}, o[d0], 0, 0, 0);   \
        o[d0] = __builtin_amdgcn_mfma_f32_32x32x16_bf16(pa2, (bf16x8){l2[0], l2[1], l2[2], l2[3], h2[0], h2[1], h2[2], h2[3]}, o[d0], 0, 0, 0);   \
        o[d0] = __builtin_amdgcn_mfma_f32_32x32x16_bf16(pa3, (bf16x8){l3[0], l3[1], l3[2], l3[3], h3[0], h3[1], h3[2], h3[3]}, o[d0], 0, 0, 0); } while (0)
    PV_D0(0); PV_D0(1); PV_D0(2); PV_D0(3);
#undef PV_D0
#undef TRRD
}
struct Blk { int mode, hg, idx; };
__device__ __forceinline__ int blk_jlo(const Blk& b) { return b.mode == MODE_WIN ? (b.idx > 8 ? b.idx - 8 : 0) : 0; }
__device__ __forceinline__ int blk_jhi(const Blk& b) { return b.mode == MODE_MOBA ? 4 * (b.idx + 1) : (b.mode == MODE_CMP ? ((4 * b.idx + 2) >> 6) + 1 : b.idx + 1); }
__device__ __forceinline__ const bf16* blk_kbase(const Blk& b, unsigned char* ws) { const bf16* z = (const bf16*)(ws + WS_C);
    return b.mode == MODE_CMP ? (const bf16*)(ws + WS_KC) + b.hg * 512 * 128 : z + (b.mode == MODE_MOBA ? MK_OFF : (b.mode == MODE_SLC ? SK_OFF : WK_OFF)) + b.hg * 128; }
__device__ __forceinline__ const bf16* blk_vbase(const Blk& b, unsigned char* ws) { const bf16* z = (const bf16*)(ws + WS_C);
    return b.mode == MODE_CMP ? (const bf16*)(ws + WS_VCT) + b.hg * 512 * 128 : z + (b.mode == MODE_MOBA ? MV_OFF : (b.mode == MODE_SLC ? SV_OFF : WV_OFF)) + b.hg * 128; }
__device__ __forceinline__ int blk_pitch(const Blk& b) { return b.mode == MODE_CMP ? 128 : ZP; }
__device__ __forceinline__ int blk_tok(const Blk& b, int wid, int r32) { return b.mode == MODE_MOBA ? 256 * b.idx + 32 * wid + r32 : 64 * b.idx + 8 * wid + (r32 >> 2); }
__device__ __forceinline__ int blk_qcol(const Blk& b, int r32) { return b.mode == MODE_MOBA ? MQ_OFF + b.hg * 128 : NQ_OFF + (4 * b.hg + (r32 & 3)) * 128; }
struct Seam { bf16x8 qr[8]; bf16x8 st_v0, st_v1, st_k0, st_k1; };
#define VMW() asm volatile("s_waitcnt vmcnt(0)" ::: "memory")
#define VMWN(n) asm volatile("s_waitcnt vmcnt(%0)" :: "i"(n) : "memory")
#define SLOAD_H(kb_, vb_, pit_, k0) do { const char* kb__ = (const char*)(kb_) + (size_t)(k0) * (pit_) * 2; const char* vb__ = (const char*)(vb_) + (size_t)(k0) * (pit_) * 2; \
                         const unsigned ro0__ = (unsigned)(sr * (pit_) + sc) * 2u, ro1__ = ro0__ + 64u * (unsigned)(pit_);              \
                         S.st_v0 = *(const GAS bf16x8*)(vb__ + ro0__); S.st_v1 = *(const GAS bf16x8*)(vb__ + ro1__);              \
                         S.st_k0 = *(const GAS bf16x8*)(kb__ + ro0__); S.st_k1 = *(const GAS bf16x8*)(kb__ + ro1__); } while (0)
#define SWRITE_HK(bf) do { *(bf16x8*)(K_lds + (bf) * SHM_K + kws) = S.st_k0; *(bf16x8*)(K_lds + (bf) * SHM_K + kws + 32 * 256) = S.st_k1; } while (0)
#define SWRITE_HV(bf) do { *(bf16x8*)(V_lds + (bf) * SHM_V + vst0) = S.st_v0; *(bf16x8*)(V_lds + (bf) * SHM_V + vst1) = S.st_v1; } while (0)
#define SWRITE_H(bf) do { SWRITE_HV(bf); SWRITE_HK(bf); } while (0)
__device__ __forceinline__ void att_prime(const Blk& cur, unsigned char* ws, char* lds, Seam& S, const int tid) {
    const bf16* z = (const bf16*)(ws + WS_C);
    const int  wid = __builtin_amdgcn_readfirstlane(tid >> 6), lane = tid & 63, r32 = lane & 31, hi = lane >> 5;
    const int sr = tid >> 4, sc = (tid & 15) * 8, kws = KSWZ(sr, sc * 2); char* K_lds = lds + 2 * SHM_V;
    const int kb0 = blk_jlo(cur) * KVBLK; const bf16* kbs = blk_kbase(cur, ws); const bf16* vbs = blk_vbase(cur, ws); const int pit = blk_pitch(cur);
    { const unsigned qoff = (unsigned)(blk_tok(cur, wid, r32) * ZP + blk_qcol(cur, r32) + hi * 8) * 2u;
#pragma unroll
      for (int d0 = 0; d0 < 8; ++d0) S.qr[d0] = *(const GAS bf16x8*)((const char*)z + qoff + d0 * 32); }
    SLOAD_H(kbs, vbs, pit, kb0); VMW(); SWRITE_HK(0);
    __syncthreads();
}
__device__ __forceinline__ void att_block(const Blk& cur, const Blk& nxt, const Args& a, char* lds, Seam& S, const int tid_in) {
    const int MODE = cur.mode; int tid = tid_in; asm volatile("" : "+v"(tid));
    unsigned char* ws = a.ws; const bf16* z = (const bf16*)(ws + WS_C);
    const int wid = __builtin_amdgcn_readfirstlane(tid >> 6), lane = tid & 63, r32 = lane & 31, hi = lane >> 5;
    const int j_lo = blk_jlo(cur), j_hi = blk_jhi(cur), NT = j_hi - j_lo;
    const int kbn = blk_jlo(nxt) * KVBLK; const bf16* kbs = blk_kbase(cur, ws); const bf16* vbs = blk_vbase(cur, ws); const int pit = blk_pitch(cur);
    const bf16* kbsn = blk_kbase(nxt, ws); const bf16* vbsn = blk_vbase(nxt, ws); const int pitn = blk_pitch(nxt);
    const int qpos = blk_tok(cur, wid, r32);
    const int qlo = MODE == MODE_MOBA ? 256 * cur.idx + 32 * wid : 64 * cur.idx + 8 * wid, qhi = qlo + (MODE == MODE_MOBA ? 31 : 7);
    const int cs = MODE == MODE_CMP ? 16 : 1; const int qm = MODE == MODE_CMP ? qpos - 31 - 64 * hi : qpos - 4 * hi; const int nearoff = MODE == MODE_CMP ? 31 : 0;
    const unsigned W = MODE == MODE_WIN ? 512u : 0x7fffffffu; const int Wedge = MODE == MODE_WIN ? 512 : 0x40000000;
    const LAS float* lutp = (const LAS float*)((LAS unsigned char*)lds + LUT_OFF) + (MODE == MODE_MOBA ? cur.hg : 8 + 4 * cur.hg + (r32 & 3)) * 128;
    LAS float* impw = (LAS float*)((LAS unsigned char*)lds + IMP_OFF) + wid * 2048;
    char* V_lds = lds; char* K_lds = lds + 2 * SHM_V;
    LAS float* wsf = (LAS float*)((LAS unsigned char*)lds + 2 * SHM_V + 2 * SHM_K) + wid * 64; LAS float* li_l = wsf; LAS float* al_l = wsf + 32;
    LAS float* li_h = li_l + 4 * hi; LAS float* al_h = al_l + 4 * hi; asm volatile("" : "+v"(li_h), "+v"(al_h));
    unsigned sw0 = 0u, sw1 = 0u, sw2 = 0u, sw3 = 0u;
    if (MODE == MODE_WIN || MODE == MODE_CMP) { sw0 = sw1 = sw2 = sw3 = 0xffffffffu; }
    if (MODE == MODE_SLC) { const LAS unsigned* sp = (const LAS unsigned*)wsf + (r32 >> 2) * 4; sw0 = sp[0]; sw1 = sp[1]; sw2 = sp[2]; sw3 = sp[3]; asm volatile("s_waitcnt lgkmcnt(0)" ::: "memory"); }
    if (MODE == MODE_MOBA) {
        const int nb = cur.idx;
        unsigned bm = 1u << nb;
        if (nb > 0) {
            int lane_o = lane; asm volatile("" : "+v"(lane_o));
            const unsigned kmo = (unsigned)((cur.hg * 32 + (lane_o & 31)) * 128 + (lane_o >> 5) * 8) * 2u; const char* kmhb = (const char*)(ws + WS_KMH); const char* kmlb = (const char*)(ws + WS_KML);
            f32x16 gs = f32x16{};
#pragma unroll
            for (int d0 = 0; d0 < 8; ++d0) { const bf16x8 ah = *(const GAS bf16x8*)(kmhb + kmo + d0 * 32), al = *(const GAS bf16x8*)(kmlb + kmo + d0 * 32);
                gs = __builtin_amdgcn_mfma_f32_32x32x16_bf16(ah, S.qr[d0], gs, 0, 0, 0); gs = __builtin_amdgcn_mfma_f32_32x32x16_bf16(al, S.qr[d0], gs, 0, 0, 0); }
            float v[32];
#pragma unroll
            for (int r = 0; r < 16; ++r) { auto rr = __builtin_amdgcn_permlane32_swap(__float_as_uint(gs[r]), __float_as_uint(gs[r]), false, false);
                const float lo = __uint_as_float(rr[0]), hv = __uint_as_float(rr[1]);
                v[(r & 3) + 8 * (r >> 2)] = lo; v[(r & 3) + 8 * (r >> 2) + 4] = hv; }
            float b1 = -__builtin_inff(), b2 = b1, b3 = b1; int i1 = -1, i2 = -1, i3 = -1;
#pragma unroll
            for (int j = 0; j < 32; ++j) { const float x = j < nb ? v[j] : -__builtin_inff();
                if (x > b1) { b3 = b2; i3 = i2; b2 = b1; i2 = i1; b1 = x; i1 = j; } else if (x > b2) { b3 = b2; i3 = i2; b2 = x; i2 = j; } else if (x > b3) { b3 = x; i3 = j; } }
            if (i1 >= 0) bm |= 1u << i1; if (i2 >= 0) bm |= 1u << i2; if (i3 >= 0) bm |= 1u << i3;
        }
#define EXP8(x) ((((x) & 1u) * 0xfu) | ((((x) >> 1) & 1u) * 0xf0u) | ((((x) >> 2) & 1u) * 0xf00u) | ((((x) >> 3) & 1u) * 0xf000u) | ((((x) >> 4) & 1u) * 0xf0000u) | ((((x) >> 5) & 1u) * 0xf00000u) | ((((x) >> 6) & 1u) * 0xf000000u) | ((((x) >> 7) & 1u) * 0xf0000000u))
        sw0 = EXP8(bm & 0xffu); sw1 = EXP8((bm >> 8) & 0xffu); sw2 = EXP8((bm >> 16) & 0xffu); sw3 = EXP8((bm >> 24) & 0xffu);
#undef EXP8
    }
    float m_reg = -1e30f, l_reg = 0; f32x16 o[4] = {f32x16{}, f32x16{}, f32x16{}, f32x16{}};
    const int sr = tid >> 4, sc = (tid & 15) * 8, vst0 = v_st(sr, sc), vst1 = v_st(32 + sr, sc), kws = KSWZ(sr, sc * 2);
    const int vb0 = (int)(uintptr_t)V_lds + v_rd_base(lane);
#define RESC(a_) do { if (__any((a_) < 1.f)) { if (hi == 0) al_l[r32] = (a_); asm volatile("s_waitcnt lgkmcnt(0)" ::: "memory");              \
                     for (int r = 0; r < 16; ++r) { const float f_ = al_h[(r & 3) + 8 * (r >> 2)]; for (int d_ = 0; d_ < 4; ++d_) o[d_][r] *= f_; } } } while (0)
#define KBASE(t) ((j_lo + (t)) * KVBLK)
#define MASKT(P0_, P1_, t) do { const int kb_ = KBASE(t); const int jt_ = j_lo + (t);                                                  \
        const unsigned wsel_ = (jt_ < 64) ? ((jt_ < 32) ? sw0 : sw1) : ((jt_ < 96) ? sw2 : sw3); const bool rs_ = (wsel_ >> (jt_ & 31)) & 1u;   \
        if (cs * (kb_ + KVBLK - 1) + nearoff > qlo - 113 || kb_ <= qhi - Wedge) mask_tile(P0_, P1_, qm - cs * kb_, cs, W, rs_, lutp);          \
        else if (!__all(rs_)) mask_rows(P0_, P1_, rs_); } while (0)
#define SEAM_K0() do { VMWN(8); SWRITE_HK(0); SBAR(); } while (0)
    f32x16 pA0, pA1, pB0, pB1; float mnA, mnB, alA, alB; bf16x8 pa0, pa1, pa2, pa3;
    SWRITE_HV(0); SBAR();
    if (NT > 1) { SLOAD_H(kbs, vbs, pit, KBASE(1)); }
    SBAR(); qkt<0>(pA0, pA1, K_lds, r32, hi, S.qr);
    MASKT(pA0, pA1, 0); partialSM(pA0, pA1, m_reg, mnA, alA);
    if (NT > 1) { VMW(); SWRITE_H(1); }
    __syncthreads();
#define HALF_STEP(PX0, PX1, mnX, alX, PY0, PY1, alY, t, KB, VB, SB) do {                                                      \
        SBAR(); qkt<KB>(PX0, PX1, K_lds, r32, hi, S.qr);                                                                      \
        finishSM(PY0, PY1, alY, l_reg, pa0, pa1, pa2, pa3); SBAR();                                                           \
        if ((t) + 1 < NT) { SLOAD_H(kbs, vbs, pit, KBASE((t) + 1)); SBAR(); }                                                        \
        pv_tile<VB>(o, vb0, pa0, pa1, pa2, pa3); MASKT(PX0, PX1, (t)); partialSM(PX0, PX1, m_reg, mnX, alX);                  \
        __syncthreads();                                                                                                      \
        if ((t) + 1 < NT) { VMW(); SWRITE_H(SB); }                                                                            \
        RESC(alX); __syncthreads(); } while (0)
    for (int t = 1; t + 1 < NT; t += 2) {
        HALF_STEP(pB0, pB1, mnB, alB, pA0, pA1, alA, t, 1, 0, 0);
        HALF_STEP(pA0, pA1, mnA, alA, pB0, pB1, alB, t + 1, 0, 1, 1);
    }
    const bool even = (NT & 1) == 0;
    if (even) { SBAR(); qkt<1>(pB0, pB1, K_lds, r32, hi, S.qr); SBAR(); }
    SLOAD_H(kbsn, vbsn, pitn, kbn); SBAR();
    { const unsigned qoff = (unsigned)(blk_tok(nxt, wid, r32) * ZP + blk_qcol(nxt, r32) + hi * 8) * 2u;
#pragma unroll
      for (int d0 = 0; d0 < 8; ++d0) S.qr[d0] = *(const GAS bf16x8*)((const char*)z + qoff + d0 * 32); }
    SBAR();
    finishSM(pA0, pA1, alA, l_reg, pa0, pa1, pa2, pa3); SBAR();
    pv_tile<0>(o, vb0, pa0, pa1, pa2, pa3);
    if (even) { MASKT(pB0, pB1, NT - 1); partialSM(pB0, pB1, m_reg, mnB, alB); __syncthreads(); RESC(alB);
        finishSM(pB0, pB1, alB, l_reg, pa0, pa1, pa2, pa3); SBAR(); pv_tile<1>(o, vb0, pa0, pa1, pa2, pa3); }
    SBAR(); SEAM_K0();
    if (hi == 0) { float f = l_reg > 0.f ? __builtin_amdgcn_rcpf(l_reg) : 0.f;
        if (MODE != MODE_MOBA) { const float gl = bf2f(z[(size_t)qpos * ZP + GL_OFF + cur.hg * 12 + (r32 & 3) * 3 + (MODE == MODE_CMP ? 0 : (MODE == MODE_SLC ? 1 : 2))]); f *= __builtin_amdgcn_rcpf(1.f + __builtin_amdgcn_exp2f(-1.4426950408889634f * gl)); }
        li_l[r32] = f;
        if (MODE == MODE_CMP) { impw[r32] = m_reg; impw[32 + r32] = l_reg; } }
    asm volatile("s_waitcnt lgkmcnt(0)" ::: "memory");
    bf16* ocat = (bf16*)(ws + WS_A); char* onp = (char*)(ws + WS_B);
#pragma unroll
    for (int r = 0; r < 16; ++r) { const int orow = crow(r, hi); const float rl = li_h[(r & 3) + 8 * (r >> 2)];
        if (MODE == MODE_MOBA) { bf16* Ow = ocat + (size_t)(qlo + orow) * DM + cur.hg * 128;
#pragma unroll
            for (int d0 = 0; d0 < 4; ++d0) { const float v = o[d0][r] * rl; const float vn = __shfl_xor(v, 1);
                if ((r32 & 1) == 0) *(unsigned*)(Ow + d0 * 32 + r32) = cvtpk(v, vn); } }
        else { const int tok = qlo + (orow >> 2), hh = 4 * cur.hg + (orow & 3); const unsigned oidx = (unsigned)(tok * 1024 + hh * 128 + r32) * 4u;
#pragma unroll
            for (int d0 = 0; d0 < 4; ++d0) { const float v = (MODE == MODE_CMP ? 0.f : *(const GAS float*)(onp + oidx + d0 * 128)) + o[d0][r] * rl;
                if (MODE != MODE_WIN) *(GAS float*)(onp + oidx + d0 * 128) = v;
                else { bf16* Ow = ocat + (size_t)tok * DM + 1024 + hh * 128; const float vn = __shfl_xor(v, 1); if ((r32 & 1) == 0) *(unsigned*)(Ow + d0 * 32 + r32) = cvtpk(v, vn); } }
            asm volatile("" ::: "memory"); } }
    __syncthreads();
#undef RESC
#undef KBASE
#undef MASKT
#undef SEAM_K0
#undef HALF_STEP
}
__device__ __forceinline__ void cmp_pass_b(int g, int cblk, unsigned char* ws, char* lds, const Seam& S, const int tid_in) {
    int tid = tid_in; asm volatile("" : "+v"(tid));
    const int wid = __builtin_amdgcn_readfirstlane(tid >> 6), lane = tid & 63, r32 = lane & 31, hi = lane >> 5;
    const int NT = ((4 * cblk + 2) >> 6) + 1;
    const int qlo = 64 * cblk + 8 * wid, tl = r32 >> 2, hl = r32 & 3, t = qlo + tl;
    const LAS float* lutp = (const LAS float*)((LAS unsigned char*)lds + LUT_OFF) + (8 + 4 * g + hl) * 128;
    LAS float* impw = (LAS float*)((LAS unsigned char*)lds + IMP_OFF) + wid * 2048; LAS float* impG = impw; LAS float* impL = impw + 1024;
    LAS float* wsf = (LAS float*)((LAS unsigned char*)lds + 2 * SHM_V + 2 * SHM_K) + wid * 64;
    const float m = impw[r32], l = impw[32 + r32];
    asm volatile("s_waitcnt lgkmcnt(0)" ::: "memory");
    const float rl = l > 0.f ? 1.f / l : 0.f, mC = m * C2;
    for (int i = lane; i < 2048; i += 64) impw[i] = 0.f;
    const bf16* kcg = (const bf16*)(ws + WS_KC) + (size_t)g * 512 * 128;
    const int sr = tid >> 4, sc = (tid & 15) * 8, kws = KSWZ(sr, sc * 2);
    const unsigned ro0 = (unsigned)(sr * 128 + sc) * 2u, ro1 = ro0 + 64u * 128u;
    bf16x8 k0 = *(const GAS bf16x8*)((const char*)kcg + ro0), k1 = *(const GAS bf16x8*)((const char*)kcg + ro1);
    *(bf16x8*)(lds + kws) = k0; *(bf16x8*)(lds + kws + 32 * 256) = k1;
    __syncthreads();
    const int qm = t - 31 - 64 * hi;
#pragma unroll 1
    for (int tt = 0; tt < NT; ++tt) {
        const int bo = (tt & 1) * SHM_V, bn = SHM_V - bo;
        if (tt + 1 < NT) { const char* kb = (const char*)kcg + (size_t)(tt + 1) * 64 * 128 * 2; k0 = *(const GAS bf16x8*)(kb + ro0); k1 = *(const GAS bf16x8*)(kb + ro1); }
        f32x16 p0 = f32x16{}, p1 = f32x16{};
        { const char* kbp[4];
#pragma unroll
          for (int dd = 0; dd < 4; ++dd) kbp[dd] = lds + bo + KSWZ(r32, (dd * 16 + hi * 8) * 2);
#pragma unroll
          for (int d0 = 0; d0 < 8; ++d0) { const char* ap = kbp[d0 & 3] + (d0 >> 2) * 128;
            const bf16x8 b0 = *reinterpret_cast<const bf16x8*>(ap), b1 = *reinterpret_cast<const bf16x8*>(ap + 32 * 256);
            p0 = __builtin_amdgcn_mfma_f32_32x32x16_bf16(b0, S.qr[d0], p0, 0, 0, 0); p1 = __builtin_amdgcn_mfma_f32_32x32x16_bf16(b1, S.qr[d0], p1, 0, 0, 0); } }
        const int kb_ = 64 * tt;
        if (16 * (kb_ + 63) + 31 > qlo - 113) mask_tile(p0, p1, qm - 16 * kb_, 16, 0x7fffffffu, true, lutp);
#pragma unroll
        for (int r = 0; r < 16; ++r) { p0[r] = __builtin_amdgcn_exp2f(fmaf(p0[r], C2, -mC)) * rl; p1[r] = __builtin_amdgcn_exp2f(fmaf(p1[r], C2, -mC)) * rl; }
#pragma unroll
        for (int a4 = 0; a4 < 4; ++a4) {
            float g0 = (p0[4 * a4] + p0[4 * a4 + 1]) + (p0[4 * a4 + 2] + p0[4 * a4 + 3]), g1 = (p1[4 * a4] + p1[4 * a4 + 1]) + (p1[4 * a4 + 2] + p1[4 * a4 + 3]);
            float e0 = p0[4 * a4 + 3], e1 = p1[4 * a4 + 3];
            g0 += __shfl_xor(g0, 1); g0 += __shfl_xor(g0, 2); g1 += __shfl_xor(g1, 1); g1 += __shfl_xor(g1, 2);
            e0 += __shfl_xor(e0, 1); e0 += __shfl_xor(e0, 2); e1 += __shfl_xor(e1, 1); e1 += __shfl_xor(e1, 2);
            if (hl == 0) { const int j0 = 16 * tt + 2 * a4 + hi; impG[tl * 128 + j0] = g0; impG[tl * 128 + j0 + 8] = g1; impL[tl * 128 + j0 + 1] = e0; if (j0 + 9 < 128) impL[tl * 128 + j0 + 9] = e1; } }
        if (tt + 1 < NT) { *(bf16x8*)(lds + bn + kws) = k0; *(bf16x8*)(lds + bn + kws + 32 * 256) = k1; }
        __syncthreads();
    }
    asm volatile("s_waitcnt lgkmcnt(0)" ::: "memory");
    const unsigned long long lt_mask = (1ull << lane) - 1ull;
    LAS unsigned* selo = (LAS unsigned*)wsf;
#pragma unroll 1
    for (int k = 0; k < 8; ++k) { const int cur = cblk; unsigned long long s0, s1;
        if (cur <= 15) { s0 = (2ull << cur) - 1ull; s1 = 0ull; }
        else {
            const int j0 = lane, j1 = lane + 64;
            const float v0 = impG[k * 128 + j0] + impL[k * 128 + j0], v1 = impG[k * 128 + j1] + impL[k * 128 + j1];
            const unsigned u0 = (j0 >= 1 && j0 <= cur - 2) ? __float_as_uint(v0) + 1u : 0u, u1 = (j1 <= cur - 2) ? __float_as_uint(v1) + 1u : 0u;
            unsigned T = 0u;
#pragma unroll 1
            for (int b = 30; b >= 0; --b) { const unsigned cand = T | (1u << b);
                const int cnt = __builtin_popcountll(__builtin_amdgcn_ballot_w64(u0 >= cand)) + __builtin_popcountll(__builtin_amdgcn_ballot_w64(u1 >= cand));
                if (cnt >= 13) T = cand; }
            const unsigned long long gt0 = __builtin_amdgcn_ballot_w64(u0 > T), gt1 = __builtin_amdgcn_ballot_w64(u1 > T);
            const unsigned long long eq0 = __builtin_amdgcn_ballot_w64(u0 == T), eq1 = __builtin_amdgcn_ballot_w64(u1 == T);
            const int need = 13 - __builtin_popcountll(gt0) - __builtin_popcountll(gt1);
            const int rk0 = __builtin_popcountll(eq0 & lt_mask), rk1 = __builtin_popcountll(eq0) + __builtin_popcountll(eq1 & lt_mask);
            const bool f0 = (j0 == 0) || (j0 == cur) || (j0 == cur - 1), f1 = (j1 == cur) || (j1 == cur - 1);
            s0 = __builtin_amdgcn_ballot_w64(f0 || u0 > T || (u0 == T && rk0 < need)); s1 = __builtin_amdgcn_ballot_w64(f1 || u1 > T || (u1 == T && rk1 < need));
        }
        if (lane == 0) { selo[k * 4 + 0] = (unsigned)s0; selo[k * 4 + 1] = (unsigned)(s0 >> 32); selo[k * 4 + 2] = (unsigned)s1; selo[k * 4 + 3] = (unsigned)(s1 >> 32); } }
    asm volatile("s_waitcnt lgkmcnt(0)" ::: "memory");
    __syncthreads();
}
__device__ __forceinline__ int item_nblk(int k) { return 4; }
__device__ __forceinline__ Blk item_blk(int k, int i) {
    Blk b; const int h = k & 7, qi = k >> 3;
    if (i == 0) { b.mode = MODE_MOBA; b.hg = h; b.idx = qi; }
    else { b.hg = h >> 2; b.idx = 127 - 4 * qi - (h & 3); b.mode = i == 1 ? MODE_CMP : (i == 2 ? MODE_SLC : MODE_WIN); }
    return b;
}
__device__ __forceinline__ void mixer_att(const Frame& F, const Args& a) {
    char* lds = (char*)F.lds;
    load_lut(F, (const float*)(a.ws + WS_LUT));
    int k = blockIdx.x; if (k >= 256) return;
    int i = 0; Blk cur = item_blk(k, 0); Seam S;
    att_prime(cur, a.ws, lds, S, F.tid);
    for (;;) {
        int kn = k, in = i + 1; bool last = false;
        if (in >= item_nblk(k)) { in = 0; kn = k + F.G; if (kn >= 256) last = true; }
        const Blk nxt = last ? cur : item_blk(kn, in);
        att_block(cur, nxt, a, lds, S, F.tid);
        if (cur.mode == MODE_CMP) cmp_pass_b(cur.hg, cur.idx, a.ws, lds, S, F.tid);
        if (last) break;
        cur = nxt; k = kn; i = in;
    }
}
}
#define MIXER_PRE_A() mx::mixer_pre_a(F, args)
#define MIXER_ATT() mx::mixer_att(F, args)
#define XB_TMO      128
#define XB_XCNT(j)  (256  + 64 * (j))
#define XB_XSUB(j)  (1280 + 64 * (j))
#define XB_XGEN(j)  (2304 + 64 * (j))
#define XB_TOP      3328
#define XB_TOPGEN   3392
#define XCD_BAR_WORDS 3456
#define XB_SPIN_CAP (1u << 18)

__device__ __forceinline__ unsigned xb_ld(unsigned* p)              { return __hip_atomic_load(p, __ATOMIC_RELAXED, __HIP_MEMORY_SCOPE_AGENT); }
__device__ __forceinline__ unsigned xb_add(unsigned* p, unsigned v) { return __hip_atomic_fetch_add(p, v, __ATOMIC_RELAXED, __HIP_MEMORY_SCOPE_AGENT); }
__device__ __forceinline__ unsigned xb_xcc_id() { return (unsigned)__builtin_amdgcn_s_getreg((3 << 11) | 20) & 0xFu; }
#define XB_SPIN(cond, bar) do { unsigned _sp = 0; while (cond) { __builtin_amdgcn_s_sleep(1); \
    if ((++_sp & 255u) == 0u) { if (xb_ld(&(bar)[XB_TMO])) break; if (_sp > XB_SPIN_CAP) { atomicAdd(&(bar)[XB_TMO], 1u); break; } } } } while (0)

struct XcdBarrier {
    unsigned* bar; unsigned x;
    volatile LAS unsigned* st;
};

__device__ __forceinline__ XcdBarrier xcd_barrier_post(unsigned* bar, volatile LAS unsigned* st) {
    XcdBarrier b; b.bar = bar; b.x = xb_xcc_id(); b.st = st;
    if (threadIdx.x == 0) (void)xb_add(&bar[XB_XCNT(b.x)], 1u);
    return b;
}
__device__ __forceinline__ void xcd_barrier_complete(unsigned* bar, unsigned x, unsigned& nloc, unsigned& nx) {
    const unsigned G = gridDim.x * gridDim.y * gridDim.z;
    unsigned sum, cnt, mine, sp = 0u;
    for (;;) {
        sum = 0u; cnt = 0u; mine = 0u;
#pragma unroll
        for (unsigned j = 0; j < 16; ++j) { const unsigned c = xb_ld(&bar[XB_XCNT(j)]); sum += c; cnt += (c > 0u) ? 1u : 0u; mine = (j == x) ? c : mine; }
        if (sum == G) break;
        __builtin_amdgcn_s_sleep(1);
        if ((++sp & 255u) == 0u) { if (xb_ld(&bar[XB_TMO])) break; if (sp > XB_SPIN_CAP) { atomicAdd(&bar[XB_TMO], 1u); break; } }
    }
    nloc = mine > 0u ? mine : 1u; nx = cnt > 0u ? cnt : 1u;
}

__device__ __forceinline__ void xcd_barrier(const XcdBarrier& b) {
    asm volatile("s_waitcnt vmcnt(0)" ::: "memory");
    __syncthreads();
    if (threadIdx.x == 0) {
        unsigned* bar = b.bar;
        __builtin_amdgcn_s_waitcnt(0);
        unsigned nloc = b.st[0], nx = b.st[1];
        if (nloc == 0u) { xcd_barrier_complete(bar, b.x, nloc, nx); b.st[0] = nloc; b.st[1] = nx; }
        const unsigned old = xb_add(&bar[XB_XSUB(b.x)], 1u);
        const unsigned gen = old / nloc;
        if (old + 1u == (gen + 1u) * nloc) {
            __builtin_amdgcn_fence(__ATOMIC_RELEASE, "agent");
            asm volatile("s_waitcnt vmcnt(0)" ::: "memory");
            const unsigned og = xb_add(&bar[XB_TOP], 1u);
            const unsigned tg = og / nx;
            if (og + 1u == (tg + 1u) * nx) xb_add(&bar[XB_TOPGEN], 1u);
            else XB_SPIN(xb_ld(&bar[XB_TOPGEN]) == tg, bar);
            __builtin_amdgcn_fence(__ATOMIC_ACQUIRE, "agent");
            xb_add(&bar[XB_XGEN(b.x)], 1u);
            asm volatile("s_waitcnt vmcnt(0)" ::: "memory");
        } else {
            XB_SPIN(xb_ld(&bar[XB_XGEN(b.x)]) == gen, bar);
            __builtin_amdgcn_fence(__ATOMIC_ACQUIRE, "agent");
            asm volatile("s_waitcnt vmcnt(0)" ::: "memory");
        }
    }
    __syncthreads();
}

__device__ __forceinline__ bool phase_begin(Frame& F) { int t = threadIdx.x; asm volatile("" : "+v"(t)); F.tid = t; F.lane = t & 63; return true; }
#ifndef N_LAUNCHES
#define N_LAUNCHES 1
#endif
#ifndef REP0
#define REP0 1
#endif
#ifndef REP1
#define REP1 1
#endif
#ifndef REP2
#define REP2 1
#endif
#ifndef REP3
#define REP3 1
#endif
#ifndef REP4
#define REP4 1
#endif
#ifndef REP5
#define REP5 1
#endif
#ifndef REP7
#define REP7 1
#endif
#ifndef REPSYNC
#define REPSYNC 0
#endif
constexpr int NPH = 9;
__global__ void __launch_bounds__(NWAVES * 64, 2) fwd_kernel(Args args) {
    extern __shared__ __attribute__((aligned(16))) unsigned char lds_raw[];
    Frame F; F.lds = (LAS unsigned char*)lds_raw; F.tid = threadIdx.x; F.lane = F.tid & 63; F.wave = __builtin_amdgcn_readfirstlane(F.tid >> 6);
    F.G = gridDim.x; F.gw = blockIdx.x * NWAVES + F.wave; F.NGW = F.G * NWAVES;
    unsigned char* ws = args.ws;
    const int lo = args.ph_lo, hi = args.ph_hi;
#ifndef PHMASK
#define PHMASK 0x1ff
#endif
#define IN(k) (((PHMASK >> (k)) & 1) && lo <= (k) && (k) < hi && phase_begin(F))
#if N_LAUNCHES == 1
    cg::grid_group grid = cg::this_grid();
    { volatile LAS unsigned* misc = (volatile LAS unsigned*)(F.lds + MISC_OFF); if (F.tid < 4) misc[F.tid] = 0u; __syncthreads(); }
    const XcdBarrier xbar = xcd_barrier_post((unsigned*)(ws + WS_CTL), (volatile LAS unsigned*)(F.lds + MISC_OFF));
#define GSYNC_CG() do { asm volatile("s_waitcnt vmcnt(0) lgkmcnt(0)" ::: "memory"); grid.sync(); __builtin_amdgcn_fence(__ATOMIC_ACQUIRE, "agent"); asm volatile("s_waitcnt vmcnt(0)" ::: "memory"); } while (0)
#define GSYNC() xcd_barrier(xbar)
#define SEAM(k) do { if (lo <= (k) && (k) + 1 < hi) { GSYNC(); } } while (0)
#else
#define SEAM(k) do { } while (0)
#endif
    bf16* const Wt_in = (bf16*)(ws + WS_B); bf16* const xb = (bf16*)(ws + WS_A); bf16* const zb = (bf16*)(ws + WS_C);
    bf16* const ocat = (bf16*)(ws + WS_A); bf16* const GE = (bf16*)(ws + WS_A); bf16* const h1 = (bf16*)(ws + WS_B); bf16* const ub = (bf16*)(ws + WS_C);
    grid.sync();
    if (IN(0)) { p0_prologue(F, args); }
#if REP0 == 2
    GSYNC_CG(); if (IN(0)) { p0_prologue(F, args); }
#endif
    SEAM(0);
    for (int rep = 0; rep < REPSYNC; ++rep) GSYNC();
    for (int rep = 0; rep < REP1; ++rep) { if (rep) GSYNC();
    if (IN(1)) { pg8::Gemm g{xb, Wt_in, S_, PROJ_PAD, DM}; pg8::StaticOrder S; S.init(S_, PROJ_PAD, F.G, (int)blockIdx.x);
        pg8::EpiBf16<0> E{zb, ZP, PROJ}; pg8::gemm_phase<pg8::EpiBf16<0>, pg8::StaticOrder, true, true>(F.lds, g, S, E, F.tid); } } SEAM(1);
    if (IN(2)) { MIXER_PRE_A(); }
#if REP2 == 2
    GSYNC(); if (IN(2)) { MIXER_PRE_A(); }
#endif
    SEAM(2);
    if (IN(3)) { MIXER_ATT(); }
    SEAM(3);
    for (int rep = 0; rep < REP5; ++rep) { if (rep) GSYNC();
    if (IN(4)) { pg8::Gemm g{ocat, (bf16*)(ws + WS_WOUT), S_, DM, DM}; pg8::StaticOrder S; S.init(S_, DM, F.G, (int)blockIdx.x);
        pg8::EpiResid E{args.in[0], args.out, DM, DN_ALPHA}; pg8::gemm_phase<pg8::EpiResid, pg8::StaticOrder, true, true>(F.lds, g, S, E, F.tid); } } SEAM(4);
#if defined(REP6) && REP6 == 2
    if (IN(5)) { ln_rows<true>(F, args.out, (float*)(ws + WS_C), (bf16*)(ws + WS_A), args.in[11], args.in[12]); } GSYNC();
#endif
    if (IN(5)) { ln_rows<true>(F, args.out, args.out, h1, args.in[11], args.in[12]); } SEAM(5);
    for (int rep = 0; rep < REP7; ++rep) { if (rep) GSYNC();
    if (IN(6)) {
#ifndef NO6A
        { pg8::Gemm g{h1, (bf16*)(ws + WS_WFF1), S_, DFF, DM}; pg8::StaticOrder S; S.init(S_, DFF, F.G, (int)blockIdx.x);
          pg8::EpiBf16<1> E{ub, DFF, DFF}; pg8::gemm_phase<pg8::EpiBf16<1>, pg8::StaticOrder, true, true>(F.lds, g, S, E, F.tid); }
#endif
#ifndef NO6B
        { pg8::Gemm g{h1, (bf16*)(ws + WS_WGATE), S_, DM, DM}; pg8::StaticOrder S; S.init(S_, DM, F.G, (int)blockIdx.x);
          pg8::EpiBf16<2> E{GE, DM, DM}; pg8::gemm_phase<pg8::EpiBf16<2>, pg8::StaticOrder, true, true>(F.lds, g, S, E, F.tid); }
#endif
#ifndef NO6C
        asm volatile("s_waitcnt vmcnt(0)" ::: "memory"); __syncthreads();
        { int kple = DPLE; asm volatile("" : "+s"(kple)); pg8::Gemm g{(bf16*)(ws + WS_PB), (bf16*)(ws + WS_WPLE), S_, DM, kple}; pg8::StaticOrder S; S.init(S_, DM, F.G, (int)blockIdx.x);
          pg8::EpiBf16<3> E{GE, DM, DM}; pg8::gemm_phase<pg8::EpiBf16<3>, pg8::StaticOrder, true, true>(F.lds, g, S, E, F.tid); }
#endif
    } } SEAM(6);
#if defined(REP8) && REP8 == 2
    if (IN(7)) { pg8::Gemm g{ub, (bf16*)(ws + WS_WFF2), S_, DM, DFF}; pg8::StaticOrder S; S.init(S_, DM, F.G, (int)blockIdx.x);
        pg8::EpiBf16<0> E{h1, DM, DM}; pg8::gemm_phase<pg8::EpiBf16<0>, pg8::StaticOrder, true, true>(F.lds, g, S, E, F.tid); } GSYNC();
#endif
    if (IN(7)) { pg8::Gemm g{ub, (bf16*)(ws + WS_WFF2), S_, DM, DFF}; pg8::StaticOrder S; S.init(S_, DM, F.G, (int)blockIdx.x);
        pg8::EpiFfn2 E{args.out, GE, DM}; pg8::gemm_phase<pg8::EpiFfn2, pg8::StaticOrder, true, true>(F.lds, g, S, E, F.tid); } SEAM(7);
#if defined(REP9) && REP9 == 2
    if (IN(8)) { ln_rows<false>(F, args.out, (float*)(ws + WS_C), nullptr, args.in[17], args.in[18]); } GSYNC();
#endif
    if (IN(8)) { ln_rows<false>(F, args.out, args.out, nullptr, args.in[17], args.in[18]); }
#undef IN
#undef SEAM
}

extern "C" void kernel_launch(void* const* d_in, const int* in_sizes, int n_in, void* d_out, int out_size, void* d_ws, size_t ws_size, hipStream_t stream) {
    static int grid = 0;
    if (grid == 0) {
        if (n_in != 19 || out_size != S_ * DM || ws_size < WS_END) { fprintf(stderr, "kernel_launch: unexpected shapes (n_in %d out %d ws %zu)\n", n_in, out_size, ws_size); grid = -1; return; }
        int dev = 0, cus = 0, per_cu = 0;
        (void)hipGetDevice(&dev); (void)hipDeviceGetAttribute(&cus, hipDeviceAttributeMultiprocessorCount, dev);
        if (hipFuncSetAttribute((const void*)fwd_kernel, hipFuncAttributeMaxDynamicSharedMemorySize, LDS_BYTES) != hipSuccess) { fprintf(stderr, "kernel_launch: hipFuncSetAttribute failed\n"); grid = -1; return; }
        if (hipOccupancyMaxActiveBlocksPerMultiprocessor(&per_cu, (const void*)fwd_kernel, NWAVES * 64, LDS_BYTES) != hipSuccess || per_cu < 1) { fprintf(stderr, "kernel_launch: occupancy query gives %d\n", per_cu); per_cu = 1; }
        (void)hipGetLastError();
        grid = cus * 1;
        if (grid <= 0) grid = 256;
    }
    if (grid < 0) return;
    (void)hipMemsetAsync((char*)d_ws + WS_CTL, 0, 16384, stream);
    Args a{};
    for (int i = 0; i < 19; ++i) a.in[i] = (const float*)d_in[i];
    a.out = (float*)d_out; a.ws = (unsigned char*)d_ws;
#if N_LAUNCHES == 1
    a.ph_lo = 0; a.ph_hi = NPH;
    void* kargs[] = {&a};
    hipError_t e = hipLaunchCooperativeKernel((const void*)fwd_kernel, dim3(grid), dim3(NWAVES * 64), kargs, LDS_BYTES, stream);
    if (e != hipSuccess) fprintf(stderr, "cooperative launch failed: %s (grid %d)\n", hipGetErrorString(e), grid);
#else
    for (int p = 0; p < NPH; ++p) { a.ph_lo = p; a.ph_hi = p + 1; hipLaunchKernelGGL(fwd_kernel, dim3(grid), dim3(NWAVES * 64), LDS_BYTES, stream, a); }
#endif
}
```
